# Optimizing an MI355X kernel written in HIP

```python
import jax, jax.numpy as jnp
from jax import lax
import numpy as np

D_MODEL = 1024
BATCH = 4
SEQ = 8192
DEPTH = 4

GRID_W = 64
CTX_LEN = 256
HEAD_DIM = 64
D_MIX = D_MODEL
H_MLSTM = D_MIX // (4 * HEAD_DIM)
H_NA = D_MIX // (2 * HEAD_DIM)
H_RET = D_MIX // (4 * HEAD_DIM)
D_M = H_MLSTM * HEAD_DIM
D_NA = H_NA * HEAD_DIM
D_R = H_RET * HEAD_DIM
MLSTM_CONV = 3
MLSTM_CHUNK = 64
RET_CHUNK = 64
NA_ROWS = 8
NA_COLS = 16
ROPE_BASE = 10000.0
N_EXPERTS = 32
TOP_K = 4
D_EXPERT = D_MODEL
SWIGLU_ALPHA = 1.702
SWIGLU_LIMIT = 7.0
MOE_BLOCK = 128
NORM_EPS = 1e-6
NEG_INF = -1e30
SPLIT_WIDTHS = (2 * D_M, D_M, D_M, 4 * H_MLSTM, D_NA, D_NA, D_NA, D_R, D_R, D_R, D_R)
SPLIT_POINTS = tuple(int(s) for s in np.cumsum(SPLIT_WIDTHS)[:-1])
D_IN = int(sum(SPLIT_WIDTHS))

kernel_name = "hybrid_mlstm_natten_retention_moe_dit"


def rms_norm(x, g):
    xf = x.astype(jnp.float32)
    y = xf * lax.rsqrt(jnp.mean(xf * xf, axis=-1, keepdims=True) + NORM_EPS)
    return (y * g.astype(jnp.float32)).astype(x.dtype)


def split_heads(t, n_heads):
    return t.reshape(t.shape[0], t.shape[1], n_heads, HEAD_DIM)


def to_bhtd(t):
    return jnp.transpose(t, (0, 2, 1, 3))


def merge_heads(t):
    b, h, t_len, d = t.shape
    return jnp.transpose(t, (0, 2, 1, 3)).reshape(b, t_len, h * d)


def flip_t(t):
    return jnp.flip(t, axis=2)


def dwconv_centred(x, w, b):
    k_size = w.shape[0]
    pad = k_size // 2
    t_len = x.shape[1]
    xp = jnp.pad(x, ((0, 0), (pad, pad), (0, 0)))
    y = b
    for i in range(k_size):
        y = y + xp[:, i:i + t_len] * w[i]
    return y


def axial_rope_tables(t_len):
    pos = jnp.arange(t_len)
    row = (pos // GRID_W).astype(jnp.float32)
    col = (pos % GRID_W).astype(jnp.float32)
    n = HEAD_DIM // 4
    inv = ROPE_BASE ** (-jnp.arange(n, dtype=jnp.float32) / n)
    ar = row[:, None] * inv
    ac = col[:, None] * inv
    return (jnp.cos(ar), jnp.sin(ar), jnp.cos(ac), jnp.sin(ac))


def rotate_half(x, cos, sin):
    x1, x2 = jnp.split(x, 2, axis=-1)
    cos = cos.astype(x.dtype)
    sin = sin.astype(x.dtype)
    return jnp.concatenate([x1 * cos - x2 * sin, x2 * cos + x1 * sin], axis=-1)


def axial_rope(x, cos_r, sin_r, cos_c, sin_c):
    xr, xc = jnp.split(x, 2, axis=-1)
    return jnp.concatenate([rotate_half(xr, cos_r, sin_r), rotate_half(xc, cos_c, sin_c)], axis=-1)


def mlstm_chunkwise(q, k, v, log_i, log_f, state0):
    b_sz, h_sz, t_len, d = q.shape
    L = MLSTM_CHUNK
    nc = t_len // L
    qc = q.reshape(b_sz, h_sz, nc, L, d)
    kc = k.reshape(b_sz, h_sz, nc, L, d)
    vc = v.reshape(b_sz, h_sz, nc, L, d)
    li = log_i.reshape(b_sz, h_sz, nc, L)
    bcum = jnp.cumsum(log_f.reshape(b_sz, h_sz, nc, L), axis=-1)
    b_tot = bcum[..., -1]
    tri = jnp.tril(jnp.ones((L, L), dtype=bool))
    d_log = jnp.where(tri, bcum[..., :, None] - bcum[..., None, :] + li[..., None, :], NEG_INF)
    m_intra = jnp.max(d_log, axis=-1)
    s = jnp.einsum('bhcjd,bhcld->bhcjl', qc, kc).astype(jnp.float32) * jnp.exp(d_log - m_intra[..., None])
    num_intra = jnp.einsum('bhcjl,bhcld->bhcjd', s, vc)
    den_intra = jnp.sum(s, axis=-1)
    w_log = b_tot[..., None] - bcum + li
    m_loc = jnp.max(w_log, axis=-1)
    e = jnp.exp(w_log - m_loc[..., None])
    c_loc = jnp.einsum('bhcl,bhcld,bhcle->bhcde', e, kc, vc)
    n_loc = jnp.einsum('bhcl,bhcld->bhcd', e, kc)

    def step(carry, inp):
        c_st, n_st, m_st = carry
        cl, nl, ml, bt = inp
        m_new = jnp.maximum(bt + m_st, ml)
        a = jnp.exp(bt + m_st - m_new)
        g = jnp.exp(ml - m_new)
        new = (a[..., None, None] * c_st + g[..., None, None] * cl, a[..., None] * n_st + g[..., None] * nl, m_new)
        return new, carry

    xs = (jnp.moveaxis(c_loc, 2, 0), jnp.moveaxis(n_loc, 2, 0), jnp.moveaxis(m_loc, 2, 0), jnp.moveaxis(b_tot, 2, 0))
    final, prev = lax.scan(step, state0, xs)
    c_prev = jnp.moveaxis(prev[0], 0, 2)
    n_prev = jnp.moveaxis(prev[1], 0, 2)
    m_prev = jnp.moveaxis(prev[2], 0, 2)
    inter_log = bcum + m_prev[..., None]
    m_q = jnp.maximum(m_intra, inter_log)
    a = jnp.exp(inter_log - m_q)
    g = jnp.exp(m_intra - m_q)
    num = a[..., None] * jnp.einsum('bhcjd,bhcde->bhcje', qc, c_prev) + g[..., None] * num_intra
    den = a * jnp.einsum('bhcjd,bhcd->bhcj', qc, n_prev) + g * den_intra
    h = num / jnp.maximum(jnp.abs(den), jnp.exp(-m_q))[..., None]
    return h.reshape(b_sz, h_sz, t_len, d), final


def retention_log_decay(first_exp):
    e = first_exp + 2.0 * jnp.arange(H_RET, dtype=jnp.float32)
    return jnp.log1p(-jnp.exp2(-e))


def retention_chunkwise(q, k, v, log_gamma, state0):
    b_sz, h_sz, t_len, d = q.shape
    L = RET_CHUNK
    nc = t_len // L
    qc = q.reshape(b_sz, h_sz, nc, L, d)
    kc = k.reshape(b_sz, h_sz, nc, L, d)
    vc = v.reshape(b_sz, h_sz, nc, L, d)
    pos = jnp.arange(L, dtype=jnp.float32)
    diff = pos[:, None] - pos[None, :]
    decay = jnp.where(diff >= 0, jnp.exp(log_gamma[:, None, None] * jnp.maximum(diff, 0.0)), 0.0)
    s = jnp.einsum('bhcjd,bhcld->bhcjl', qc, kc).astype(jnp.float32) * decay[:, None]
    intra = jnp.einsum('bhcjl,bhcld->bhcjd', s, vc)
    zeta = jnp.exp(log_gamma[:, None] * (L - 1 - pos))
    s_loc = jnp.einsum('hl,bhcld,bhcle->bhcde', zeta, kc, vc)
    g_chunk = jnp.exp(log_gamma * L)[:, None, None]

    def step(r, sl):
        return g_chunk * r + sl, r

    final, r_prev = lax.scan(step, state0, jnp.moveaxis(s_loc, 2, 0))
    r_prev = jnp.moveaxis(r_prev, 0, 2)
    xi = jnp.exp(log_gamma[:, None] * (pos + 1.0))
    inter = jnp.einsum('bhcjd,bhcde->bhcje', qc, r_prev) * xi[:, None, :, None]
    return (intra + inter).reshape(b_sz, h_sz, t_len, d), final


def na_window(rows):
    wr = min(NA_ROWS, rows)
    r = jnp.arange(rows)
    col = jnp.arange(GRID_W)
    row_idx = jnp.clip(r - wr // 2, 0, rows - wr)[:, None] + jnp.arange(wr)[None, :]
    col_start = jnp.clip(col - NA_COLS // 2, 0, GRID_W - NA_COLS)
    col_in = (col[None, :] >= col_start[:, None]) & (col[None, :] < col_start[:, None] + NA_COLS)
    dr = row_idx - r[:, None] + NA_ROWS - 1
    dc = jnp.clip(col[None, :] - col[:, None] + NA_COLS - 1, 0, 2 * NA_COLS - 2)
    return (row_idx, col_in, dr[:, None, :, None], dc[None, :, None, :])


def na_latent(q, k, v, k_ctx, v_ctx, row_idx, col_in, bias):
    t_len, h_sz, d = q.shape
    rows, wr = row_idx.shape
    scale = d ** -0.5
    qg = q.reshape(rows, GRID_W, h_sz, d)
    kb = k.reshape(rows, GRID_W, h_sz, d)[row_idx]
    vb = v.reshape(rows, GRID_W, h_sz, d)[row_idx]
    s_loc = jnp.einsum('rqhd,rjwhd->hrqjw', qg, kb).astype(jnp.float32) * scale + bias
    s_loc = jnp.where(col_in[:, None, :], s_loc, NEG_INF)
    s_ctx = jnp.einsum('rqhd,chd->hrqc', qg, k_ctx).astype(jnp.float32) * scale
    n_loc = wr * GRID_W
    s = jnp.concatenate([s_loc.reshape(h_sz, rows, GRID_W, n_loc), s_ctx], axis=-1)
    p = jax.nn.softmax(s, axis=-1).astype(v.dtype)
    p_loc = p[..., :n_loc].reshape(h_sz, rows, GRID_W, wr, GRID_W)
    o = jnp.einsum('hrqjw,rjwhd->rqhd', p_loc, vb) + jnp.einsum('hrqc,chd->rqhd', p[..., n_loc:], v_ctx)
    return o.reshape(t_len, h_sz * d)


def ctx_attention(q, k, v):
    s = jnp.einsum('bqhd,bkhd->bhqk', q, k).astype(jnp.float32) * HEAD_DIM ** -0.5
    p = jax.nn.softmax(s, axis=-1).astype(v.dtype)
    o = jnp.einsum('bhqk,bkhd->bqhd', p, v)
    return o.reshape(o.shape[0], o.shape[1], -1)


def hybrid_mixer(px, pc, rope, na_win, conv_w, conv_b, gate_b, m_norm, q_norm, k_norm, rpb, r_norm, ctx_out):
    b_sz = px.shape[0]
    xp = jnp.split(px, SPLIT_POINTS, axis=-1)
    cp = jnp.split(pc, SPLIT_POINTS, axis=-1)

    def mlstm_prep(p):
        qk = jax.nn.silu(dwconv_centred(p[0], conv_w, conv_b))
        q, k = jnp.split(qk, 2, axis=-1)
        g = (p[3] + gate_b).astype(jnp.float32)
        g = jnp.transpose(g.reshape(b_sz, -1, 4, H_MLSTM), (2, 0, 3, 1))
        return (to_bhtd(split_heads(q, H_MLSTM)), to_bhtd(split_heads(k, H_MLSTM)) * HEAD_DIM ** -0.5,
                to_bhtd(split_heads(p[1], H_MLSTM)), g[0], jax.nn.log_sigmoid(g[1]), g[2], jax.nn.log_sigmoid(g[3]))

    qx, kx, vx, ix_f, lfx_f, ix_b, lfx_b = mlstm_prep(xp)
    qc, kc, vc, ic_f, lfc_f, ic_b, lfc_b = mlstm_prep(cp)
    zero_m = (jnp.zeros((b_sz, H_MLSTM, HEAD_DIM, HEAD_DIM), jnp.float32),
              jnp.zeros((b_sz, H_MLSTM, HEAD_DIM), jnp.float32), jnp.zeros((b_sz, H_MLSTM), jnp.float32))
    hc_f, st_f = mlstm_chunkwise(qc, kc, vc, ic_f, lfc_f, zero_m)
    hc_b, st_b = mlstm_chunkwise(flip_t(qc), flip_t(kc), flip_t(vc), flip_t(ic_b), flip_t(lfc_b), zero_m)
    hx_f, _ = mlstm_chunkwise(qx, kx, vx, ix_f, lfx_f, st_f)
    hx_b, _ = mlstm_chunkwise(flip_t(qx), flip_t(kx), flip_t(vx), flip_t(ix_b), flip_t(lfx_b), st_b)

    def mlstm_out(h, o):
        return merge_heads(rms_norm(h, m_norm)).astype(o.dtype) * jax.nn.sigmoid(o)

    a_x = mlstm_out(hx_f + flip_t(hx_b), xp[2])

    def na_prep(p):
        return (rms_norm(split_heads(p[4], H_NA), q_norm), rms_norm(split_heads(p[5], H_NA), k_norm),
                split_heads(p[6], H_NA))

    nqx, nkx, nvx = na_prep(xp)
    nqc, nkc, nvc = na_prep(cp)
    row_idx, col_in, dr, dc = na_win
    bias = rpb[:, dr, dc].astype(jnp.float32)
    b_x = lax.map(lambda a: na_latent(a[0], a[1], a[2], a[3], a[4], row_idx, col_in, bias),
                  (nqx, nkx, nvx, nkc, nvc))

    lg_f = retention_log_decay(5.0)
    lg_b = retention_log_decay(6.0)
    rqx = axial_rope(to_bhtd(split_heads(xp[7], H_RET)), *rope)
    rkx = axial_rope(to_bhtd(split_heads(xp[8], H_RET)), *rope) * HEAD_DIM ** -0.5
    rvx = to_bhtd(split_heads(xp[9], H_RET))
    rqc = to_bhtd(split_heads(cp[7], H_RET))
    rkc = to_bhtd(split_heads(cp[8], H_RET)) * HEAD_DIM ** -0.5
    rvc = to_bhtd(split_heads(cp[9], H_RET))
    zero_r = jnp.zeros((b_sz, H_RET, HEAD_DIM, HEAD_DIM), jnp.float32)
    rc_f, rs_f = retention_chunkwise(rqc, rkc, rvc, lg_f, zero_r)
    rc_b, rs_b = retention_chunkwise(flip_t(rqc), flip_t(rkc), flip_t(rvc), lg_b, zero_r)
    rx_f, _ = retention_chunkwise(rqx, rkx, rvx, lg_f, rs_f)
    rx_b, _ = retention_chunkwise(flip_t(rqx), flip_t(rkx), flip_t(rvx), lg_b, rs_b)

    def ret_out(h, g):
        return merge_heads(rms_norm(h, r_norm)).astype(g.dtype) * jax.nn.silu(g)

    c_x = ret_out(rx_f + flip_t(rx_b), xp[10])
    mix_x = jnp.concatenate([a_x, b_x, c_x], axis=-1)
    if not ctx_out:
        return mix_x, None
    a_c = mlstm_out(hc_f + flip_t(hc_b), cp[2])
    b_c = ctx_attention(nqc, nkc, nvc)
    c_c = ret_out(rc_f + flip_t(rc_b), cp[10])
    return mix_x, jnp.concatenate([a_c, b_c, c_c], axis=-1)


def clamped_swiglu(up):
    glu = jnp.minimum(up[..., ::2], SWIGLU_LIMIT)
    lin = jnp.clip(up[..., 1::2], -SWIGLU_LIMIT, SWIGLU_LIMIT)
    return glu * jax.nn.sigmoid(SWIGLU_ALPHA * glu) * (lin + 1.0)


def moe_ffn(h, w_r, b_r, w_up, b_up, w_down, b_down):
    n_tok, d = h.shape
    logits = (h @ w_r + b_r).astype(jnp.float32)
    top_v, top_e = lax.top_k(logits, TOP_K)
    gates = jax.nn.softmax(top_v, axis=-1)
    n_as = n_tok * TOP_K
    flat_e = top_e.reshape(n_as)
    order = jnp.argsort(flat_e)
    e_sorted = flat_e[order]
    tok_sorted = order // TOP_K
    counts = jnp.bincount(flat_e, length=N_EXPERTS)
    padded = (counts + MOE_BLOCK - 1) // MOE_BLOCK * MOE_BLOCK
    end_pad = jnp.cumsum(padded)
    start_pad = end_pad - padded
    start = jnp.cumsum(counts) - counts
    dest = start_pad[e_sorted] + jnp.arange(n_as) - start[e_sorted]
    n_blocks = -(-n_as // MOE_BLOCK) + N_EXPERTS
    n_rows = n_blocks * MOE_BLOCK
    row_tok = jnp.full((n_rows,), n_tok, dtype=jnp.int32).at[dest].set(tok_sorted.astype(jnp.int32))
    h_pad = jnp.concatenate([h, jnp.zeros((1, d), h.dtype)], axis=0)
    x_blocks = h_pad[row_tok].reshape(n_blocks, MOE_BLOCK, d)
    blk_e = jnp.minimum(jnp.searchsorted(end_pad, jnp.arange(n_blocks) * MOE_BLOCK, side='right'), N_EXPERTS - 1)

    def expert_block(args):
        xb, e = args
        return clamped_swiglu(xb @ w_up[e] + b_up[e]) @ w_down[e] + b_down[e]

    y = lax.map(expert_block, (x_blocks, blk_e)).reshape(n_rows, d)
    y_as = y[dest] * gates.reshape(n_as)[order][:, None].astype(y.dtype)
    return jax.ops.segment_sum(y_as, tok_sorted, num_segments=n_tok)


def setup_inputs(seed: int = 0) -> dict:
    key = jax.random.key(seed)
    ks = jax.random.split(key, 24)
    f32 = jnp.float32

    def normal(k, shape, scale):
        return jax.random.normal(k, shape, f32) * scale

    D, L, E, F = D_MODEL, DEPTH, N_EXPERTS, D_EXPERT
    fb = jnp.linspace(3.0, 6.0, H_MLSTM)
    gate_pattern = jnp.stack([jnp.zeros_like(fb), fb, jnp.zeros_like(fb), fb])
    gate_b = (normal(ks[11], (L, 4, H_MLSTM), 0.1) + gate_pattern).reshape(L, 4 * H_MLSTM)
    return {
        "x": normal(ks[0], (BATCH, SEQ, D), 1.0),
        "c": normal(ks[1], (BATCH, D), 1.0),
        "ctx": normal(ks[2], (BATCH, CTX_LEN, D), 1.0),
        "c_ctx": normal(ks[3], (D,), 1.0),
        "w_mod": normal(ks[4], (L, D, 6 * D), 0.5 * D ** -0.5),
        "b_mod": normal(ks[5], (L, 6 * D), 0.02),
        "norm_mix": 1.0 + normal(ks[6], (L, D), 0.02),
        "norm_ffn": 1.0 + normal(ks[7], (L, D), 0.02),
        "w_in": normal(ks[8], (L, D, D_IN), D ** -0.5),
        "w_out": normal(ks[9], (L, D_MIX, D), D_MIX ** -0.5),
        "mlstm_conv_w": normal(ks[10], (L, MLSTM_CONV, 2 * D_M), MLSTM_CONV ** -0.5),
        "mlstm_conv_b": normal(ks[12], (L, 2 * D_M), 0.02),
        "mlstm_gate_b": gate_b,
        "mlstm_norm": 1.0 + normal(ks[13], (L, HEAD_DIM), 0.02),
        "na_q_norm": 1.0 + normal(ks[14], (L, HEAD_DIM), 0.02),
        "na_k_norm": 1.0 + normal(ks[15], (L, HEAD_DIM), 0.02),
        "na_rpb": normal(ks[16], (L, H_NA, 2 * NA_ROWS - 1, 2 * NA_COLS - 1), 0.1),
        "ret_norm": 1.0 + normal(ks[17], (L, HEAD_DIM), 0.02),
        "router_w": normal(ks[18], (L, D, E), D ** -0.5),
        "router_b": normal(ks[19], (L, E), 0.01),
        "expert_w_up": normal(ks[20], (L, E, D, 2 * F), D ** -0.5),
        "expert_b_up": normal(ks[21], (L, E, 2 * F), 0.02),
        "expert_w_down": normal(ks[22], (L, E, F, D), F ** -0.5),
        "expert_b_down": normal(ks[23], (L, E, D), 0.02),
    }


def reference(x, c, ctx, c_ctx, w_mod, b_mod, norm_mix, norm_ffn, w_in, w_out,
              mlstm_conv_w, mlstm_conv_b, mlstm_gate_b, mlstm_norm,
              na_q_norm, na_k_norm, na_rpb, ret_norm,
              router_w, router_b, expert_w_up, expert_b_up, expert_w_down, expert_b_down):
    b_sz, t_len, d = x.shape
    t_ctx = ctx.shape[1]
    rows = t_len // GRID_W
    rope = axial_rope_tables(t_len)
    na_win = na_window(rows)
    for l in range(DEPTH):
        ctx_out = l < DEPTH - 1
        mx = jnp.split(jax.nn.silu(c) @ w_mod[l] + b_mod[l], 6, axis=-1)
        sh1, sc1, g1, sh2, sc2, g2 = [m[:, None, :] for m in mx]
        sh1c, sc1c, g1c, sh2c, sc2c, g2c = jnp.split(jax.nn.silu(c_ctx) @ w_mod[l] + b_mod[l], 6, axis=-1)
        hx = rms_norm(x, norm_mix[l]) * (1.0 + sc1) + sh1
        hc = rms_norm(ctx, norm_mix[l]) * (1.0 + sc1c) + sh1c
        mix_x, mix_c = hybrid_mixer(hx @ w_in[l], hc @ w_in[l], rope, na_win,
                                    mlstm_conv_w[l], mlstm_conv_b[l], mlstm_gate_b[l], mlstm_norm[l],
                                    na_q_norm[l], na_k_norm[l], na_rpb[l], ret_norm[l], ctx_out)
        x = x + g1 * (mix_x @ w_out[l])
        if ctx_out:
            ctx = ctx + g1c * (mix_c @ w_out[l])
        tok = (rms_norm(x, norm_ffn[l]) * (1.0 + sc2) + sh2).reshape(b_sz * t_len, d)
        if ctx_out:
            tok_c = (rms_norm(ctx, norm_ffn[l]) * (1.0 + sc2c) + sh2c).reshape(b_sz * t_ctx, d)
            tok = jnp.concatenate([tok, tok_c], axis=0)
        y = moe_ffn(tok, router_w[l], router_b[l], expert_w_up[l], expert_b_up[l], expert_w_down[l], expert_b_down[l])
        x = x + g2 * y[:b_sz * t_len].reshape(b_sz, t_len, d)
        if ctx_out:
            ctx = ctx + g2c * y[b_sz * t_len:].reshape(b_sz, t_ctx, d)
    return x
```

```cpp
#include <hip/hip_runtime.h>
#include <cstdio>
#include <cstdint>

#ifndef MK_ONE_LAUNCH
#define MK_ONE_LAUNCH 1
#endif

constexpr int D = 1024, NB = 4, SEQ = 8192, DEPTH = 4, CTXL = 256;
constexpr int ML = NB * SEQ;
constexpr int MC = NB * CTXL;
constexpr int MT = ML + MC;
constexpr int DIN = 3600, NPX = 3840;
constexpr int NE = 32;
constexpr int NCH = 132;
constexpr int NSEQ = 32;
constexpr int CAP = MT;
constexpr int MOE_TILES_MAX = 560;
constexpr float EPS = 1e-6f;
constexpr int C_MQ = 0, C_MK = 256, C_MV = 512, C_MO = 768, C_NQ = 1024, C_NK = 1536, C_NV = 2048, C_RQ = 2560, C_RK = 2816, C_RV = 3072, C_RG = 3328, C_GATE = 3584;

constexpr size_t MiB = 1u << 20;
constexpr size_t WS_CTL = 0, CTL_ZERO_BYTES = 1 * MiB;
constexpr size_t WS_MOD = 1 * MiB;
constexpr size_t WS_ROPE = 2 * MiB;
constexpr size_t WS_MISC = 3 * MiB;
constexpr size_t WS_X = 4 * MiB;
constexpr size_t WS_ACT = 136 * MiB;
constexpr size_t WS_PX = 202 * MiB;
constexpr size_t WS_MIX = 450 * MiB;
constexpr size_t WS_CLOC = 516 * MiB;
constexpr size_t WS_RLOC = 582 * MiB;
constexpr size_t WS_CPREV = 648 * MiB;
constexpr size_t WS_RPREV = 681 * MiB;
constexpr size_t WS_NLOC = 714 * MiB;
constexpr size_t WS_NPREV = 716 * MiB;
constexpr size_t WS_ROWTOK = 719 * MiB;
constexpr size_t WS_ROWGATE = 724 * MiB;
constexpr size_t WS_TOKSLOT = 729 * MiB;
constexpr size_t WS_H = 730 * MiB;
constexpr size_t WS_Y = 1010 * MiB;
constexpr size_t WS_WIN = 1290 * MiB;
constexpr size_t WS_WOUT = 1320 * MiB;
constexpr size_t WS_WUP = 1328 * MiB;
constexpr size_t WS_WDN = 1840 * MiB;
constexpr size_t WS_KN = 2096 * MiB;
constexpr size_t WS_VTB = 2198 * MiB;
constexpr size_t WS_QK2 = 2130 * MiB;
constexpr size_t WS_DLT = 2300 * MiB;
constexpr size_t WS_END = 2366 * MiB;
constexpr int VTB_H = 24;
constexpr int CW_TMO = 0, CW_BAR = 4096, CW_CNT = 8192;

constexpr int LDS_BYTES = 147456;
constexpr int LDSCTL_OFF = 143360;
constexpr int NWAVES = 8, NTHR = 512;

#define GAS __attribute__((address_space(1)))
#define LAS __attribute__((address_space(3)))
typedef unsigned short bf16;
typedef unsigned v4u __attribute__((ext_vector_type(4)));
typedef unsigned v2u __attribute__((ext_vector_type(2)));
typedef float f32x4 __attribute__((ext_vector_type(4)));
typedef short bf16x8 __attribute__((ext_vector_type(8)));
#define RLX_AGENT __ATOMIC_RELAXED, __HIP_MEMORY_SCOPE_AGENT
#define LDS_WAIT() asm volatile("s_waitcnt lgkmcnt(0)" ::: "memory")

__device__ __forceinline__ unsigned cvt_pk_bf16(float lo, float hi) { unsigned r; asm volatile("v_cvt_pk_bf16_f32 %0, %1, %2" : "=v"(r) : "v"(lo), "v"(hi)); return r; }
__device__ __forceinline__ bf16 f2bf(float f) { return (bf16)(cvt_pk_bf16(f, 0.f) & 0xffffu); }
__device__ __forceinline__ float bf2f(unsigned b) { return __uint_as_float(b << 16); }
__device__ __forceinline__ float bflo(unsigned u) { return __uint_as_float(u << 16); }
__device__ __forceinline__ float bfhi(unsigned u) { return __uint_as_float(u & 0xffff0000u); }
__device__ __forceinline__ void unpack8(v4u r, float (&o)[8]) { o[0] = bflo(r.x); o[1] = bfhi(r.x); o[2] = bflo(r.y); o[3] = bfhi(r.y); o[4] = bflo(r.z); o[5] = bfhi(r.z); o[6] = bflo(r.w); o[7] = bfhi(r.w); }
__device__ __forceinline__ v4u pack8(const float (&o)[8]) { v4u r; r.x = cvt_pk_bf16(o[0], o[1]); r.y = cvt_pk_bf16(o[2], o[3]); r.z = cvt_pk_bf16(o[4], o[5]); r.w = cvt_pk_bf16(o[6], o[7]); return r; }
__device__ __forceinline__ int opq_tid() { int t = threadIdx.x; asm volatile("" : "+v"(t)); return t; }
__device__ __forceinline__ float shx(float v, int m, int lane) { return __int_as_float(__builtin_amdgcn_ds_bpermute((lane ^ m) << 2, __float_as_int(v))); }
__device__ __forceinline__ int shxi(int v, int m, int lane) { return __builtin_amdgcn_ds_bpermute((lane ^ m) << 2, v); }
__device__ __forceinline__ float shsrc(float v, int src) { return __int_as_float(__builtin_amdgcn_ds_bpermute(src << 2, __float_as_int(v))); }
__device__ __forceinline__ int shsrci(int v, int src) { return __builtin_amdgcn_ds_bpermute(src << 2, v); }
__device__ __forceinline__ float wave_sum(float v, int lane) {
#pragma unroll
    for (int o = 1; o < 64; o <<= 1) v += shx(v, o, lane);
    return v;
}
__device__ __forceinline__ float wave_max(float v, int lane) {
#pragma unroll
    for (int o = 1; o < 64; o <<= 1) v = fmaxf(v, shx(v, o, lane));
    return v;
}
__device__ __forceinline__ float sigmoidf_(float z) { return __builtin_amdgcn_rcpf(1.0f + __expf(-z)); }
__device__ __forceinline__ float siluf_(float z) { return z * __builtin_amdgcn_rcpf(1.0f + __expf(-z)); }
__device__ __forceinline__ float logsigmoidf_(float z) { return fminf(z, 0.f) - __logf(1.0f + __expf(-fabsf(z))); }
__device__ __forceinline__ f32x4 mfma16(bf16x8 a, bf16x8 b, f32x4 c) { return __builtin_amdgcn_mfma_f32_16x16x32_bf16(a, b, c, 0, 0, 0); }
__device__ __forceinline__ bf16x8 as_frag(v4u v) { return __builtin_bit_cast(bf16x8, v); }

#define XB_TMO      128
#define XB_XCNT(j)  (256  + 64 * (j))
#define XB_XSUB(j)  (1280 + 64 * (j))
#define XB_XGEN(j)  (2304 + 64 * (j))
#define XB_TOP      3328
#define XB_TOPGEN   3392
#define XCD_BAR_WORDS 3456
#define XB_SPIN_CAP (1u << 18)
__device__ __forceinline__ unsigned xb_ld(unsigned* p)              { return __hip_atomic_load(p, __ATOMIC_RELAXED, __HIP_MEMORY_SCOPE_AGENT); }
__device__ __forceinline__ unsigned xb_add(unsigned* p, unsigned v) { return __hip_atomic_fetch_add(p, v, __ATOMIC_RELAXED, __HIP_MEMORY_SCOPE_AGENT); }
__device__ __forceinline__ unsigned xb_xcc_id() { return (unsigned)__builtin_amdgcn_s_getreg((3 << 11) | 20) & 0xFu; }
#define XB_SPIN(cond, bar) do { unsigned _sp = 0; while (cond) { __builtin_amdgcn_s_sleep(1); \
    if ((++_sp & 255u) == 0u) { if (xb_ld(&(bar)[XB_TMO])) break; if (_sp > XB_SPIN_CAP) { atomicAdd(&(bar)[XB_TMO], 1u); break; } } } } while (0)
struct XcdBarrier { unsigned* bar; unsigned x; volatile LAS unsigned* st; };
__device__ __forceinline__ XcdBarrier xcd_barrier_post(unsigned* bar, volatile LAS unsigned* st) {
    XcdBarrier b; b.bar = bar; b.x = xb_xcc_id(); b.st = st;
    if (threadIdx.x == 0) (void)xb_add(&bar[XB_XCNT(b.x)], 1u);
    return b;
}
__device__ __forceinline__ void xcd_barrier_complete(unsigned* bar, unsigned x, unsigned& nloc, unsigned& nx) {
    const unsigned G = gridDim.x * gridDim.y * gridDim.z;
    unsigned sum, cnt, mine, sp = 0u;
    for (;;) {
        sum = 0u; cnt = 0u; mine = 0u;
#pragma unroll
        for (unsigned j = 0; j < 16; ++j) { const unsigned c = xb_ld(&bar[XB_XCNT(j)]); sum += c; cnt += (c > 0u) ? 1u : 0u; mine = (j == x) ? c : mine; }
        if (sum == G) break;
        __builtin_amdgcn_s_sleep(1);
        if ((++sp & 255u) == 0u) { if (xb_ld(&bar[XB_TMO])) break; if (sp > XB_SPIN_CAP) { atomicAdd(&bar[XB_TMO], 1u); break; } }
    }
    nloc = mine > 0u ? mine : 1u; nx = cnt > 0u ? cnt : 1u;
}
__device__ __forceinline__ void xcd_barrier(const XcdBarrier& b) {
    asm volatile("s_waitcnt vmcnt(0)" ::: "memory");
    __syncthreads();
    if (threadIdx.x == 0) {
        unsigned* bar = b.bar;
        __builtin_amdgcn_s_waitcnt(0);
        unsigned nloc = b.st[0], nx = b.st[1];
        if (nloc == 0u) { xcd_barrier_complete(bar, b.x, nloc, nx); b.st[0] = nloc; b.st[1] = nx; }
        const unsigned old = xb_add(&bar[XB_XSUB(b.x)], 1u);
        const unsigned gen = old / nloc;
        if (old + 1u == (gen + 1u) * nloc) {
            __builtin_amdgcn_fence(__ATOMIC_RELEASE, "agent");
            asm volatile("s_waitcnt vmcnt(0)" ::: "memory");
            const unsigned og = xb_add(&bar[XB_TOP], 1u);
            const unsigned tg = og / nx;
            if (og + 1u == (tg + 1u) * nx) xb_add(&bar[XB_TOPGEN], 1u);
            else XB_SPIN(xb_ld(&bar[XB_TOPGEN]) == tg, bar);
            __builtin_amdgcn_fence(__ATOMIC_ACQUIRE, "agent");
            xb_add(&bar[XB_XGEN(b.x)], 1u);
            asm volatile("s_waitcnt vmcnt(0)" ::: "memory");
        } else {
            XB_SPIN(xb_ld(&bar[XB_XGEN(b.x)]) == gen, bar);
            __builtin_amdgcn_fence(__ATOMIC_ACQUIRE, "agent");
            asm volatile("s_waitcnt vmcnt(0)" ::: "memory");
        }
    }
    __syncthreads();
}

namespace pg8 {
#define PG8_LAS __attribute__((address_space(3)))
constexpr int BM = 256, BK = 64, HALF = 128, HTB = HALF * BK * 2, STAGE_BYTES = 8 * HTB, NXCD = 8, WGM = 8;
constexpr int GK = 1024;
constexpr unsigned HSTEP = (unsigned)HALF * GK * 2;
constexpr size_t TSTEP = (size_t)2 * HSTEP;
__host__ __device__ __forceinline__ int lds_byte(int r, int c) { const int st = (r >> 4) * 2 + (c >> 5), rr = r & 15, cc = c & 31, ob = rr * 64 + cc * 2; return st * 1024 + (ob ^ (((ob >> 9) & 1) << 5)); }
__host__ __device__ __forceinline__ void stage_rc(int b, int& R, int& C) { const int st = b / 1024, sb = b % 1024, swz = sb ^ (((sb >> 9) & 1) << 5); R = (st >> 1) * 16 + swz / 64; C = (st & 1) * 32 + (swz % 64) / 2; }
__host__ __device__ __forceinline__ int perm32(int rho) { const int n = rho >> 4, i = rho & 15; return 8 * (i >> 2) + 4 * n + (i & 3); }

typedef int v8i_t __attribute__((ext_vector_type(8)));
typedef int v4i_t __attribute__((ext_vector_type(4)));
__device__ __forceinline__ v8i_t cat8(bf16x8 lo, bf16x8 hi) { const v4i_t a = __builtin_bit_cast(v4i_t, lo), b = __builtin_bit_cast(v4i_t, hi); return __builtin_shufflevector(a, b, 0, 1, 2, 3, 4, 5, 6, 7); }
constexpr int YROWS = 143360;
struct Unit { int pm, pn, e, jt, cnt; };

struct DenseSched {
    const char* A; const char* B; int nM, nN, nwg, G, c; size_t tstep;
    unsigned long long cmap; int i0, lbase;
    __device__ __forceinline__ void init(const void* A_, const void* B_, int M, int N, int G_, int c_, size_t tstep_ = TSTEP) { tstep = tstep_; A = (const char*)A_; B = (const char*)B_; nM = M / BM; nN = N / BM; nwg = nM * nN; G = G_; c = c_;
        cmap = 0xFEDCBA9876543210ull; i0 = 0; lbase = 0; }
    __device__ __forceinline__ void part(unsigned long long cmap_, int lbase_) { cmap = cmap_; lbase = lbase_; i0 = c < lbase_ ? (lbase_ - c + G - 1) / G : 0; }
    __device__ __forceinline__ bool next(int i, Unit& u) const {
        const long L = (long)(i + i0) * G + c - lbase; if (L >= nwg) return false;
        int wgid = (int)L; { const int q = nwg / NXCD, r = nwg % NXCD, xcd = wgid % NXCD, off = wgid / NXCD; wgid = (xcd < r ? xcd * (q + 1) : r * (q + 1) + (xcd - r) * q) + off; }
        const int nig = WGM * nN, gid = wgid / nig, fm = gid * WGM, gsz = (nM - fm) < WGM ? (nM - fm) : WGM;
        u.pm = fm + ((wgid % nig) % gsz); u.pn = (int)((cmap >> (4 * ((wgid % nig) / gsz))) & 15ull); u.e = 0; u.jt = 0; u.cnt = 0; return true;
    }
    static constexpr bool GATHERS = false;
    __device__ __forceinline__ const char* a_base(const Unit& u) const { return A + (size_t)u.pm * tstep; }
    __device__ __forceinline__ const char* b_base(const Unit& u) const { return B + (size_t)u.pn * tstep; }
    __device__ __forceinline__ void a_offs(const Unit&, unsigned (&)[2][2], const int (&)[2], const int (&)[2]) const {}
};
template <bool GATHER> struct MoeSched {
    static constexpr unsigned RBm = 1024u;
    const PG8_LAS int* tstart; const PG8_LAS int* ecnt; const char* A; const char* B; const int* rowtok; size_t bstride; int ntiles, nN, G, c;
    __device__ __forceinline__ bool next(int i, Unit& u) const {
        const int L = i * G + c; if (L >= ntiles * nN) return false;
        u.pm = L / nN; u.pn = L % nN;
        const int e = tstart[128 + u.pm];
        u.e = e; u.jt = u.pm - tstart[e]; u.cnt = ecnt[e]; return true;
    }
    static constexpr bool GATHERS = GATHER;
    __device__ __forceinline__ const char* a_base(const Unit& u) const { return GATHER ? A : A + (size_t)u.pm * (256u * RBm); }
    __device__ __forceinline__ const char* b_base(const Unit& u) const { return B + (size_t)u.e * bstride + (size_t)u.pn * (256u * RBm); }
    __device__ __forceinline__ void a_offs(const Unit& u, unsigned (&vo)[2][2], const int (&R)[2], const int (&C)[2]) const {
#pragma unroll
        for (int h = 0; h < 2; ++h)
#pragma unroll
            for (int i = 0; i < 2; ++i) {
                if (GATHER) { const int rr = u.jt * 256 + h * 128 + R[i]; const int tok = (rr < u.cnt) ? rowtok[(size_t)u.e * CAP + rr] : 0; vo[h][i] = (unsigned)tok * RBm + (unsigned)C[i] * 2u; }
            }
    }
};

constexpr float WSC = 16.0f, WSC_INV = 1.0f / 16.0f;
constexpr float YSC = 16.0f, YSC_INV = 1.0f / 16.0f;
__device__ __forceinline__ unsigned pk4_fp8(float a, float b, float c, float d) { int w = 0; w = __builtin_amdgcn_cvt_pk_fp8_f32(a, b, w, false); w = __builtin_amdgcn_cvt_pk_fp8_f32(c, d, w, true); return (unsigned)w; }
template <bool F8_> struct EpiBf16T {
    static constexpr bool PERM = true, F8 = F8_, SWP = false, HGRP = false;
    bf16* O; int ldc;
    __device__ __forceinline__ void operator()(const f32x4 (&acc)[2][2][4][2], const Unit& u, int wr, int wc, int fr, int fq) const {
        const int row0 = u.pm * BM + wr * 64 + fr, col0 = u.pn * BM + wc * 32 + 8 * fq;
#pragma unroll
        for (int ai = 0; ai < 2; ++ai)
#pragma unroll
            for (int m = 0; m < 4; ++m) { const int row = row0 + ai * HALF + m * 16;
#pragma unroll
                for (int bj = 0; bj < 2; ++bj) { const f32x4 v0 = F8_ ? acc[ai][bj][m][0] * WSC_INV : acc[ai][bj][m][0], v1 = F8_ ? acc[ai][bj][m][1] * WSC_INV : acc[ai][bj][m][1]; const int c = col0 + bj * HALF;
                    v4u w; w.x = cvt_pk_bf16(v0[0], v0[1]); w.y = cvt_pk_bf16(v0[2], v0[3]); w.z = cvt_pk_bf16(v1[0], v1[1]); w.w = cvt_pk_bf16(v1[2], v1[3]);
                    *(v4u*)(O + ((size_t)(c >> 6) * ldc + row) * 64 + (c & 63)) = w; } }
    }
};
template <bool SWP_> struct EpiInProj {
    static constexpr bool PERM = true, F8 = true, SWP = SWP_, HGRP = false;
    static constexpr int NST = 16;
    bf16* O; int ldc; bf16* VT; unsigned char* G8; const float* rope; unsigned char* qk8;
    __device__ __forceinline__ void operator()(const f32x4 (&acc)[2][2][4][2], const Unit& u, int wr, int wc, int fr, int fq) const {
        if constexpr (SWP_) {
            const int hb = u.pn == 2 ? 8 : (u.pn == 8 ? 0 : (u.pn == 9 ? 4 : 12));
#pragma unroll
            for (int ai = 0; ai < 2; ++ai)
#pragma unroll
                for (int mp = 0; mp < 2; ++mp) { const int ublk = u.pm * 8 + ai * 4 + wr * 2 + mp;
#pragma unroll
                    for (int bj = 0; bj < 2; ++bj)
#pragma unroll
                        for (int n = 0; n < 2; ++n) { const int cl = bj * HALF + wc * 32 + 8 * (fr >> 2) + 4 * n + (fr & 3);
                            const f32x4 v0 = acc[ai][bj][2 * mp][n] * WSC_INV, v1 = acc[ai][bj][2 * mp + 1][n] * WSC_INV;
                            v4u w; w.x = cvt_pk_bf16(v0[0], v0[1]); w.y = cvt_pk_bf16(v0[2], v0[3]); w.z = cvt_pk_bf16(v1[0], v1[1]); w.w = cvt_pk_bf16(v1[2], v1[3]);
                            *(v4u*)(VT + ((((size_t)ublk * VTB_H + hb + (cl >> 6)) * 4 + fq) * 64 + (cl & 63)) * 8) = w; } }
            return;
        }
        const int row0 = u.pm * BM + wr * 64 + fr, col0 = u.pn * BM + wc * 32 + 8 * fq;
        const bool gate_tile = u.pn == 14;
        if (gate_tile && (wc != 0 || fq >= 2)) return;
        if (u.pn == 10 || u.pn == 11) {
            const bool isk = u.pn == 11, mainrow = u.pm < ML / BM; const float sc = (isk ? 0.125f : 1.0f) * 4.0f * WSC_INV;
            const int half = wc & 1, lane = fr + 16 * fq; const float sg = fq >= 2 ? 1.0f : -1.0f;
#pragma unroll
            for (int ai = 0; ai < 2; ++ai)
#pragma unroll
                for (int m = 0; m < 4; ++m) { const int row = row0 + ai * HALF + m * 16, t = row & (SEQ - 1), pos = half ? 128 + (t & 63) : (t >> 6);
                    const float* cs = rope + ((size_t)pos * 16 + 8 * (fq & 1)) * 2;
                    f32x4 c4[4];
#pragma unroll
                    for (int q4 = 0; q4 < 4; ++q4) c4[q4] = mainrow ? *(const f32x4*)(cs + 4 * q4) : (f32x4){1.f, 0.f, 1.f, 0.f};
#pragma unroll
                    for (int bj = 0; bj < 2; ++bj) { float o[8];
#pragma unroll
                        for (int j = 0; j < 8; ++j) { const float x = acc[ai][bj][m][j >> 2][j & 3]; const float xp = shx(x, 32, lane);
                            o[j] = (x * c4[j >> 1][(j & 1) * 2] + sg * xp * c4[j >> 1][(j & 1) * 2 + 1]) * sc; }
                        v2u w; w.x = pk4_fp8(o[0], o[1], o[2], o[3]); w.y = pk4_fp8(o[4], o[5], o[6], o[7]);
                        *(v2u*)(qk8 + ((size_t)(8 + (isk ? 4 : 0) + 2 * bj + (wc >> 1)) * ldc + row) * 64 + half * 32 + 8 * fq) = w; } }
            return;
        }
        if (u.pn == 3 || u.pn == 13) {
            const int cc0 = (u.pn == 3 ? 0 : BM) + wc * 32 + 8 * fq;
#pragma unroll
            for (int ai = 0; ai < 2; ++ai)
#pragma unroll
                for (int m = 0; m < 4; ++m) { const int row = row0 + ai * HALF + m * 16;
#pragma unroll
                    for (int bj = 0; bj < 2; ++bj) { const f32x4 v0 = acc[ai][bj][m][0] * 0.25f, v1 = acc[ai][bj][m][1] * 0.25f; const int c = cc0 + bj * HALF;
                        v2u w; w.x = pk4_fp8(v0[0], v0[1], v0[2], v0[3]); w.y = pk4_fp8(v1[0], v1[1], v1[2], v1[3]);
                        *(v2u*)(G8 + ((size_t)(c >> 6) * ldc + row) * 64 + (c & 63)) = w; } }
            return;
        }
#pragma unroll
        for (int ai = 0; ai < 2; ++ai)
#pragma unroll
            for (int m = 0; m < 4; ++m) { const int row = row0 + ai * HALF + m * 16;
#pragma unroll
                for (int bj = 0; bj < 2; ++bj) { if (bj == 1 && gate_tile) continue;
                    const f32x4 v0 = acc[ai][bj][m][0] * WSC_INV, v1 = acc[ai][bj][m][1] * WSC_INV; const int c = col0 + bj * HALF;
                    v4u w; w.x = cvt_pk_bf16(v0[0], v0[1]); w.y = cvt_pk_bf16(v0[2], v0[3]); w.z = cvt_pk_bf16(v1[0], v1[1]); w.w = cvt_pk_bf16(v1[2], v1[3]);
                    *(v4u*)(O + ((size_t)(c >> 6) * ldc + row) * 64 + (c & 63)) = w; } }
    }
};
struct EpiInProjK {
    static constexpr bool PERM = true, F8 = true, SWP = false, HGRP = true;
    static constexpr int NST = 16;
    bf16* KN; const float* kw;
    __device__ __forceinline__ void operator()(const f32x4 (&acc)[2][2][4][2], const Unit& u, int wr, int wc, int fr, int fq) const {
        const int row0 = u.pm * BM + wr * 64 + fr, head = (u.pn - 6) * 4 + wc, lane = fr + 16 * fq;
        f32x4 kv[2][2];
#pragma unroll
        for (int bj = 0; bj < 2; ++bj)
#pragma unroll
            for (int n = 0; n < 2; ++n) kv[bj][n] = *(const f32x4*)(kw + bj * 32 + 8 * fq + 4 * n);
#pragma unroll
        for (int ai = 0; ai < 2; ++ai)
#pragma unroll
            for (int m = 0; m < 4; ++m) { const int row = row0 + ai * HALF + m * 16;
                f32x4 x[2][2]; float ss = 0.f;
#pragma unroll
                for (int bj = 0; bj < 2; ++bj)
#pragma unroll
                    for (int n = 0; n < 2; ++n) { x[bj][n] = acc[ai][bj][m][n] * WSC_INV; ss += (x[bj][n][0] * x[bj][n][0] + x[bj][n][1] * x[bj][n][1]) + (x[bj][n][2] * x[bj][n][2] + x[bj][n][3] * x[bj][n][3]); }
                ss += shx(ss, 16, lane); ss += shx(ss, 32, lane);
                const float rn = rsqrtf(ss * (1.0f / 64.0f) + EPS);
#pragma unroll
                for (int bj = 0; bj < 2; ++bj) { const f32x4 v0 = x[bj][0] * rn * kv[bj][0], v1 = x[bj][1] * rn * kv[bj][1];
                    v4u w; w.x = cvt_pk_bf16(v0[0], v0[1]); w.y = cvt_pk_bf16(v0[2], v0[3]); w.z = cvt_pk_bf16(v1[0], v1[1]); w.w = cvt_pk_bf16(v1[2], v1[3]);
                    *(v4u*)(KN + ((size_t)head * MT + row) * 64 + bj * 32 + 8 * fq) = w; } }
    }
};
struct EpiResGate {
    static constexpr bool PERM = true, F8 = true, SWP = false, HGRP = false; static constexpr int NST = 16;
    bf16* O; const float* mod;
    __device__ __forceinline__ void operator()(const f32x4 (&acc)[2][2][4][2], const Unit& u, int wr, int wc, int fr, int fq) const {
        const int row0 = u.pm * BM + wr * 64 + fr, col0 = u.pn * BM + wc * 32 + 8 * fq;
        const int mb = u.pm < 128 ? (u.pm >> 5) : 4;
        const float* g = mod + (size_t)mb * 6144 + col0;
        v4u xin[2][4][2];
#pragma unroll
        for (int ai = 0; ai < 2; ++ai)
#pragma unroll
            for (int m = 0; m < 4; ++m)
#pragma unroll
                for (int bj = 0; bj < 2; ++bj) xin[ai][m][bj] = *(const v4u*)(O + (size_t)(row0 + ai * HALF + m * 16) * D + col0 + bj * HALF);
        f32x4 gv[2][2];
#pragma unroll
        for (int bj = 0; bj < 2; ++bj)
#pragma unroll
            for (int n = 0; n < 2; ++n) gv[bj][n] = *(const f32x4*)(g + bj * HALF + 4 * n) * WSC_INV;
#pragma unroll
        for (int ai = 0; ai < 2; ++ai)
#pragma unroll
            for (int m = 0; m < 4; ++m) { bf16* rowp = O + (size_t)(row0 + ai * HALF + m * 16) * D + col0;
#pragma unroll
                for (int bj = 0; bj < 2; ++bj) { const v4u xi = xin[ai][m][bj];
                    const f32x4 x0 = (f32x4){bflo(xi.x), bfhi(xi.x), bflo(xi.y), bfhi(xi.y)}, x1 = (f32x4){bflo(xi.z), bfhi(xi.z), bflo(xi.w), bfhi(xi.w)};
                    const f32x4 v0 = x0 + acc[ai][bj][m][0] * gv[bj][0], v1 = x1 + acc[ai][bj][m][1] * gv[bj][1];
                    v4u w; w.x = cvt_pk_bf16(v0[0], v0[1]); w.y = cvt_pk_bf16(v0[2], v0[3]); w.z = cvt_pk_bf16(v1[0], v1[1]); w.w = cvt_pk_bf16(v1[2], v1[3]);
                    *(v4u*)(rowp + bj * HALF) = w; } }
    }
};
struct EpiSwiglu {
    static constexpr bool PERM = true, F8 = true, SWP = false, HGRP = false;
    unsigned char* H; const float* bup;
    __device__ __forceinline__ void operator()(const f32x4 (&acc)[2][2][4][2], const Unit& u, int wr, int wc, int fr, int fq) const {
        const int row0 = u.pm * BM + wr * 64 + fr, j0 = u.pn * 128 + wc * 32 + 8 * fq;
        const float* bp = bup + (size_t)u.e * 2048 + 2 * j0;
        f32x4 bq[4];
#pragma unroll
        for (int q = 0; q < 4; ++q) bq[q] = *(const f32x4*)(bp + 4 * q);
#pragma unroll
        for (int ai = 0; ai < 2; ++ai)
#pragma unroll
            for (int m = 0; m < 4; ++m) { unsigned char* rowp = H + (size_t)(row0 + ai * HALF + m * 16) * 1024 + j0;
                float o[8];
#pragma unroll
                for (int n = 0; n < 2; ++n)
#pragma unroll
                    for (int i = 0; i < 4; ++i) { const int q = 2 * n + (i >> 1);
                        float glu = acc[ai][0][m][n][i] * WSC_INV + bq[q][(i & 1) * 2], lin = acc[ai][1][m][n][i] * WSC_INV + bq[q][(i & 1) * 2 + 1];
                        glu = fminf(glu, 7.0f); lin = fminf(fmaxf(lin, -7.0f), 7.0f);
                        const float ex = __builtin_amdgcn_exp2f(glu * (-1.702f * 1.4426950408889634f));
                        o[4 * n + i] = glu * __builtin_amdgcn_rcpf(1.0f + ex) * (lin + 1.0f); }
                v2u w; w.x = pk4_fp8(o[0], o[1], o[2], o[3]); w.y = pk4_fp8(o[4], o[5], o[6], o[7]);
                *(v2u*)rowp = w; }
    }
};
struct EpiDown {
    static constexpr bool PERM = true, F8 = true, SWP = false, HGRP = false; static constexpr int NST = 16;
    unsigned char* Y; const float* bd; const float* rowgate;
    __device__ __forceinline__ void operator()(const f32x4 (&acc)[2][2][4][2], const Unit& u, int wr, int wc, int fr, int fq) const {
        const int row0 = u.pm * BM + wr * 64 + fr, col0 = u.pn * BM + wc * 32 + 8 * fq;
        const float* bp = bd + (size_t)u.e * 1024 + col0;
        f32x4 bv[2][2];
#pragma unroll
        for (int bj = 0; bj < 2; ++bj)
#pragma unroll
            for (int n = 0; n < 2; ++n) bv[bj][n] = *(const f32x4*)(bp + bj * HALF + 4 * n) * YSC;
#pragma unroll
        for (int ai = 0; ai < 2; ++ai)
#pragma unroll
            for (int m = 0; m < 4; ++m) {
                const int row = row0 + ai * HALF + m * 16;
#pragma unroll
                for (int bj = 0; bj < 2; ++bj) { const f32x4 v0 = acc[ai][bj][m][0] * (WSC_INV * YSC) + bv[bj][0], v1 = acc[ai][bj][m][1] * (WSC_INV * YSC) + bv[bj][1]; const int c = col0 + bj * HALF;
                    v2u w; w.x = pk4_fp8(v0[0], v0[1], v0[2], v0[3]); w.y = pk4_fp8(v1[0], v1[1], v1[2], v1[3]);
                    *(v2u*)(Y + ((size_t)(c >> 6) * YROWS + row) * 64 + (c & 63)) = w; } }
    }
};

template <class Epi, class Sched>
__device__ __forceinline__ void gemm_phase(PG8_LAS unsigned char* lds, const Sched& S, const Epi& E) {
    const int tid = opq_tid(), wid = __builtin_amdgcn_readfirstlane(tid >> 6), lane = tid & 63, wr = wid >> 2, wc = wid & 3, fr = lane & 15, fq = lane >> 4;
    constexpr bool F8 = Epi::F8;
    constexpr unsigned RB = F8 ? 1024u : 2048u;
    constexpr int nt = F8 ? 8 : 16;
    constexpr bool GA = Sched::GATHERS;
    int RA[2], CA[2]; unsigned voffA[2], voffB[2];
#pragma unroll
    for (int i = 0; i < 2; ++i) { int R, C; stage_rc(tid * 16 + i * 8192, R, C); const int Rb = Epi::HGRP ? ((R >> 5) * 64 + perm32(R & 31)) : (Epi::PERM ? ((R & ~31) + perm32(R & 31)) : R);
        RA[i] = R; CA[i] = C; voffA[i] = (unsigned)R * RB + (unsigned)C * 2u; voffB[i] = (unsigned)Rb * RB + (unsigned)C * 2u; }
    constexpr size_t kstep = (size_t)(BK * 2);
    constexpr size_t hstep = (size_t)HALF * RB;
    constexpr size_t bhstep = Epi::HGRP ? (size_t)32 * RB : hstep;
    const unsigned ldsw = (unsigned)wid * 1024u;
    const int aoff = lds_byte(wr * 64 + fr, fq * 8), boff = lds_byte(wc * 32 + fr, fq * 8);
#define PG8_SA(b, h) (((b) * 2 + (h)) * HTB)
#define PG8_SB(b, h) ((4 + (b) * 2 + (h)) * HTB)
#define PG8_STAGE(bufoff, gbase, voff) do { _Pragma("unroll") for (int _i = 0; _i < 2; ++_i) \
        __builtin_amdgcn_global_load_lds((const unsigned*)((const char*)(gbase) + (voff)[_i]), (PG8_LAS unsigned*)(lds + (bufoff) + ldsw + _i * 8192), 16, 0, 0); } while (0)
#define PG8_LDA(dst, b, h) do { _Pragma("unroll") for (int m = 0; m < 4; ++m) _Pragma("unroll") for (int k = 0; k < 2; ++k) dst[m][k] = *(const PG8_LAS bf16x8*)(lds + PG8_SA(b, h) + aoff + m * 2048 + k * 1024); } while (0)
#define PG8_LDB(dst, b, h) do { _Pragma("unroll") for (int n = 0; n < 2; ++n) _Pragma("unroll") for (int k = 0; k < 2; ++k) dst[n][k] = *(const PG8_LAS bf16x8*)(lds + PG8_SB(b, h) + boff + n * 2048 + k * 1024); } while (0)
#define PG8_MMA(ai, bj, At, Bt) do { __builtin_amdgcn_s_setprio(1); _Pragma("unroll") for (int m = 0; m < 4; ++m) _Pragma("unroll") for (int n = 0; n < 2; ++n) { \
        if constexpr (F8) { const v8i_t _a = cat8(Bt[n][0], Bt[n][1]), _b = cat8(At[m][0], At[m][1]); \
            if constexpr (Epi::SWP) asm volatile("v_mfma_scale_f32_16x16x128_f8f6f4 %0, %2, %1, %0, %3, %3 op_sel_hi:[0,0,0]" : "+v"(acc[ai][bj][m][n]) : "v"(_a), "v"(_b), "v"(f8scale)); \
            else asm volatile("v_mfma_scale_f32_16x16x128_f8f6f4 %0, %1, %2, %0, %3, %3 op_sel_hi:[0,0,0]" : "+v"(acc[ai][bj][m][n]) : "v"(_a), "v"(_b), "v"(f8scale)); } \
        else { _Pragma("unroll") for (int k = 0; k < 2; ++k) acc[ai][bj][m][n] = __builtin_amdgcn_mfma_f32_16x16x32_bf16(Bt[n][k], At[m][k], acc[ai][bj][m][n], 0, 0, 0); } } __builtin_amdgcn_s_setprio(0); } while (0)
#define PG8_STA(bufoff, gbase, h, vo) do { if constexpr (GA) { PG8_STAGE(bufoff, gbase, vo[h]); } else { PG8_STAGE(bufoff, (gbase) + (h) * hstep, voffA); } } while (0)
#define PG8_WAIT_V(n) asm volatile("s_waitcnt vmcnt(" #n ")" ::: "memory")
#define PG8_WAIT_L(n) asm volatile("s_waitcnt lgkmcnt(" #n ")" ::: "memory")
#define PG8_BAR __builtin_amdgcn_s_barrier()
#define PG8_SCHED __builtin_amdgcn_sched_barrier(0)
    Unit cur, nxt; int ui = 0;
    if (!S.next(0, cur)) return;
    f32x4 acc[2][2][4][2];
#pragma unroll
    for (int a = 0; a < 2; ++a)
#pragma unroll
        for (int b = 0; b < 2; ++b)
#pragma unroll
            for (int m = 0; m < 4; ++m)
#pragma unroll
                for (int n = 0; n < 2; ++n) acc[a][b][m][n] = (f32x4){0.f, 0.f, 0.f, 0.f};
    bf16x8 At[4][2], B0[2][2], B1[2][2];
    const int f8scale = 0x7f7f7f7f;
    unsigned voA[2][2], nvoA[2][2];
    const char* cA = S.a_base(cur); const char* cB = S.b_base(cur);
    if constexpr (GA) S.a_offs(cur, voA, RA, CA);
    PG8_STAGE(PG8_SB(0, 0), cB, voffB); PG8_STAGE(PG8_SB(0, 1), cB + bhstep, voffB); PG8_STA(PG8_SA(0, 0), cA, 0, voA); PG8_STA(PG8_SA(0, 1), cA, 1, voA);
    if (wr == 1) PG8_BAR;
    PG8_WAIT_V(2); PG8_BAR;
    PG8_STAGE(PG8_SB(1, 0), cB + kstep, voffB); PG8_STA(PG8_SA(1, 0), cA + kstep, 0, voA); PG8_STAGE(PG8_SB(1, 1), cB + bhstep + kstep, voffB);
    PG8_WAIT_V(6); PG8_BAR;
    for (;;) {
        const bool has_next = S.next(ui + 1, nxt);
        const char* nA = has_next ? S.a_base(nxt) : cA; const char* nB = has_next ? S.b_base(nxt) : cB;
        if constexpr (GA) {
            if (has_next) S.a_offs(nxt, nvoA, RA, CA);
            else {
#pragma unroll
                for (int h = 0; h < 2; ++h)
#pragma unroll
                    for (int i = 0; i < 2; ++i) nvoA[h][i] = voA[h][i];
            }
        }
#pragma unroll 1
        for (int t = 0; t < nt; t += 2) {
            const bool last = (t == nt - 2);
            const char* a1 = cA + (size_t)(t + 1) * kstep;
            const char* a2 = last ? nA : cA + (size_t)(t + 2) * kstep; const char* b2 = last ? nB : cB + (size_t)(t + 2) * kstep;
            const char* a3 = a2 + kstep; const char* b3 = b2 + kstep;
            unsigned xo[2][2];
            if constexpr (GA) {
#pragma unroll
                for (int h = 0; h < 2; ++h)
#pragma unroll
                    for (int i = 0; i < 2; ++i) xo[h][i] = last ? nvoA[h][i] : voA[h][i];
            }
            PG8_LDB(B0, 0, 0); PG8_LDB(B1, 0, 1); PG8_SCHED; PG8_LDA(At, 0, 0); PG8_STA(PG8_SA(1, 1), a1, 1, voA);
            PG8_WAIT_V(8); PG8_WAIT_L(0); PG8_BAR; PG8_MMA(0, 0, At, B0); PG8_MMA(0, 1, At, B1); PG8_BAR; PG8_SCHED;
            PG8_LDA(At, 0, 1); PG8_STAGE(PG8_SB(0, 0), b2, voffB); PG8_STAGE(PG8_SB(0, 1), b2 + bhstep, voffB); PG8_STA(PG8_SA(0, 0), a2, 0, xo);
            PG8_WAIT_V(8); PG8_WAIT_L(0); PG8_BAR; PG8_MMA(1, 0, At, B0); PG8_MMA(1, 1, At, B1); PG8_BAR; PG8_SCHED;
            PG8_LDB(B0, 1, 0); PG8_LDB(B1, 1, 1); PG8_SCHED; PG8_LDA(At, 1, 0); PG8_STA(PG8_SA(0, 1), a2, 1, xo);
            PG8_WAIT_V(8); PG8_WAIT_L(0); PG8_BAR; PG8_MMA(0, 0, At, B0); PG8_MMA(0, 1, At, B1); PG8_BAR; PG8_SCHED;
            PG8_LDA(At, 1, 1); PG8_STAGE(PG8_SB(1, 0), b3, voffB); PG8_STAGE(PG8_SB(1, 1), b3 + bhstep, voffB); PG8_STA(PG8_SA(1, 0), a3, 0, xo);
            PG8_WAIT_V(8); PG8_WAIT_L(0); PG8_BAR; PG8_MMA(1, 0, At, B0); PG8_MMA(1, 1, At, B1); PG8_BAR; PG8_SCHED;
        }
        if (wr == 0) PG8_BAR;
        if constexpr (F8) asm volatile("s_nop 15\n\ts_nop 15" ::: "memory");
        { const int t2 = opq_tid() & 63; E(acc, cur, wr, wc, t2 & 15, t2 >> 4); }
        if (!has_next) break;
#pragma unroll
        for (int a = 0; a < 2; ++a)
#pragma unroll
            for (int b = 0; b < 2; ++b)
#pragma unroll
                for (int m = 0; m < 4; ++m)
#pragma unroll
                    for (int n = 0; n < 2; ++n) acc[a][b][m][n] = (f32x4){0.f, 0.f, 0.f, 0.f};
        cur = nxt; cA = nA; cB = nB; ++ui;
        if constexpr (GA) {
#pragma unroll
            for (int h = 0; h < 2; ++h)
#pragma unroll
                for (int i = 0; i < 2; ++i) voA[h][i] = nvoA[h][i];
        }
        if (wr == 1) PG8_BAR;
    }
    PG8_WAIT_V(0);
    PG8_BAR;
#undef PG8_SA
#undef PG8_SB
#undef PG8_STAGE
#undef PG8_STA
#undef PG8_LDA
#undef PG8_LDB
#undef PG8_MMA
#undef PG8_WAIT_V
#undef PG8_WAIT_L
#undef PG8_BAR
#undef PG8_SCHED
}
}

struct Args { const float* in[24]; float* out; unsigned char* ws; int ph_lo, ph_hi; };
enum { I_X = 0, I_C, I_CTX, I_CCTX, I_WMOD, I_BMOD, I_NMIX, I_NFFN, I_WIN, I_WOUT, I_CONVW, I_CONVB, I_GATEB, I_MNORM, I_QNORM, I_KNORM, I_RPB, I_RNORM, I_RW, I_RB, I_WUP, I_BUP, I_WDN, I_BDN };

typedef const __attribute__((address_space(4))) Args KArgs;
__device__ __forceinline__ KArgs& get_args() { unsigned long long p = (unsigned long long)__builtin_amdgcn_kernarg_segment_ptr(); asm volatile("" : "+s"(p)); return *(KArgs*)p; }
__device__ __forceinline__ size_t pxo(int row, int c) { return ((size_t)(c >> 6) * MT + row) * 64 + (c & 63); }
constexpr float QSC = 4.0f, QSC_INV = 1.0f / 4.0f;
static_assert(QSC == 4.0f, "the in-projection's rope epilogue hard-codes the QK8 scale");
constexpr float GSC = 4.0f, GSC_INV = 1.0f / 4.0f;
constexpr size_t WS_VTK8 = WS_QK2 + 36 * MiB;
__device__ __forceinline__ void unpack8f8(v2u r, float (&o)[8], float sc) {
    const auto a = __builtin_amdgcn_cvt_pk_f32_fp8((int)r.x, false), b = __builtin_amdgcn_cvt_pk_f32_fp8((int)r.x, true), c = __builtin_amdgcn_cvt_pk_f32_fp8((int)r.y, false), d = __builtin_amdgcn_cvt_pk_f32_fp8((int)r.y, true);
    o[0] = a[0] * sc; o[1] = a[1] * sc; o[2] = b[0] * sc; o[3] = b[1] * sc; o[4] = c[0] * sc; o[5] = c[1] * sc; o[6] = d[0] * sc; o[7] = d[1] * sc; }
__device__ __forceinline__ int chunk_row(int b, int cc) { return cc < 4 ? ML + b * CTXL + cc * 64 : b * SEQ + (cc - 4) * 64; }
__device__ __forceinline__ int vcu_of(int bx, int G) { return (G % 8 == 0) ? (bx % 8) * (G / 8) + bx / 8 : bx; }

template <int MODE> __device__ __forceinline__ int dest_row(int s) {
    if (MODE == 1) return s < 1024 ? s : (s < 1040 ? C_GATE + (s - 1024) : s - 16);
    if (MODE == 2) { const int j = s >> 1, bj = s & 1; return ((j >> 7) << 8) + (bj << 7) + (j & 127); }
    return s;
}
template <int MODE> __device__ __forceinline__ void transpose_item(const float* W, int K, int N, bf16* WT, LAS float* scr, int item, int lane) {
    const int nblk = (N + 63) / 64, kb = item / nblk, nb = item % nblk, k0 = 64 * kb, n0 = 64 * nb;
    const int n = n0 + lane; const bool ok = n < N;
    const float* src = W + (size_t)k0 * N + (ok ? n : 0);
#pragma unroll 16
    for (int i = 0; i < 64; ++i) { const float v = src[(size_t)i * N]; scr[i * 65 + lane] = ok ? v : 0.f; }
    LDS_WAIT(); asm volatile("" ::: "memory");
    const int c = lane & 7;
#pragma unroll
    for (int j = 0; j < 8; ++j) { const int nn = (lane >> 3) + 8 * j; const int s = n0 + nn; const LAS float* p = scr + (8 * c) * 65 + nn;
        v4u o; o.x = cvt_pk_bf16(p[0], p[65]); o.y = cvt_pk_bf16(p[130], p[195]); o.z = cvt_pk_bf16(p[260], p[325]); o.w = cvt_pk_bf16(p[390], p[455]);
        if (s < N) *(v4u*)(WT + (size_t)dest_row<MODE>(s) * K + k0 + 8 * c) = o; }
    LDS_WAIT(); asm volatile("" ::: "memory");
}
__device__ __forceinline__ void phase_prologue(LAS unsigned char* lds) {
    KArgs& A = get_args();
    const int tid = opq_tid(), lane = tid & 63, wave = __builtin_amdgcn_readfirstlane(tid >> 6);
    const int G = gridDim.x, gw = blockIdx.x * NWAVES + wave, NGW = G * NWAVES;
    unsigned char* ws = A.ws;
    {
        float* rope = (float*)(ws + WS_ROPE);
        for (int i = blockIdx.x * NTHR + tid; i < 192 * 16; i += G * NTHR) { const int pos = i >> 4, f = i & 15; const float p = (float)(pos < 128 ? pos : pos - 128);
            const float inv = powf(10000.0f, -(float)f / 16.0f); const float a = p * inv; rope[2 * i] = cosf(a); rope[2 * i + 1] = sinf(a); }
    }
    {
        LAS float* scr = (LAS float*)(lds + wave * 16640);
        constexpr int I_IN = 16 * 57, I_OUT = 16 * 16, I_UP = 16 * 32, I_DN = 16 * 16;
        constexpr int N_IN = DEPTH * I_IN, N_OUT = DEPTH * I_OUT, N_UP = DEPTH * NE * I_UP, N_DN = DEPTH * NE * I_DN, N_ALL = N_IN + N_OUT + N_UP + N_DN;
        const float* src = nullptr; bf16* wt = nullptr; int N = 0, n0 = 0, k0 = 0, mode = 0; bool ok = false;
        const float* nsrc = nullptr; bf16* nwt = nullptr; int nN = 0, nn0 = 0, nk0 = 0, nmode = 0; bool nok = false;
#define TDECODE(it_, src_, wt_, N_, n0_, k0_, mode_, ok_) do { int r = (it_), item; const float* W; \
            if (r < N_IN) { const int l2 = r / I_IN; item = r % I_IN; W = A.in[I_WIN] + (size_t)l2 * D * DIN; wt_ = (bf16*)(ws + WS_WIN + (size_t)l2 * NPX * D); N_ = DIN; mode_ = 1; } \
            else if ((r -= N_IN) < N_OUT) { const int l2 = r / I_OUT; item = r % I_OUT; W = A.in[I_WOUT] + (size_t)l2 * D * D; wt_ = (bf16*)(ws + WS_WOUT + (size_t)l2 * D * D); N_ = D; mode_ = 0; } \
            else if ((r -= N_OUT) < N_UP) { const int le = r / I_UP; item = r % I_UP; W = A.in[I_WUP] + (size_t)le * D * 2048; wt_ = (bf16*)(ws + WS_WUP + (size_t)le * 2048 * D); N_ = 2048; mode_ = 2; } \
            else { r -= N_UP; const int le = r / I_DN; item = r % I_DN; W = A.in[I_WDN] + (size_t)le * D * D; wt_ = (bf16*)(ws + WS_WDN + (size_t)le * D * D); N_ = D; mode_ = 3; } \
            const int nblk = (N_ + 63) / 64; k0_ = 64 * (item / nblk); n0_ = 64 * (item % nblk); ok_ = (n0_ + lane) < N_; src_ = W + (size_t)k0_ * N_ + (ok_ ? n0_ + lane : 0); } while (0)
        float cur[64], nxt[64];
        int it = gw;
        if (it < N_ALL) { TDECODE(it, src, wt, N, n0, k0, mode, ok);
#pragma unroll
            for (int i = 0; i < 64; ++i) cur[i] = __builtin_nontemporal_load(src + (size_t)i * N); }
        for (; it < N_ALL; it += NGW) {
            const bool has_next = it + NGW < N_ALL;
            if (has_next) { TDECODE(it + NGW, nsrc, nwt, nN, nn0, nk0, nmode, nok);
#pragma unroll
                for (int i = 0; i < 64; ++i) nxt[i] = __builtin_nontemporal_load(nsrc + (size_t)i * nN); }
#pragma unroll
            for (int i = 0; i < 64; ++i) scr[i * 65 + lane] = ok ? cur[i] : 0.f;
            LDS_WAIT(); asm volatile("" ::: "memory");
            const int c = lane & 7;
#pragma unroll
            for (int j = 0; j < 8; ++j) { const int nn = (lane >> 3) + 8 * j; const int sc_ = n0 + nn; const LAS float* p = scr + (8 * c) * 65 + nn;
                const int dr = mode == 1 ? dest_row<1>(sc_) : (mode == 2 ? dest_row<2>(sc_) : sc_);
                if (mode >= 0) { v2u o; o.x = pg8::pk4_fp8(p[0] * pg8::WSC, p[65] * pg8::WSC, p[130] * pg8::WSC, p[195] * pg8::WSC); o.y = pg8::pk4_fp8(p[260] * pg8::WSC, p[325] * pg8::WSC, p[390] * pg8::WSC, p[455] * pg8::WSC);
                    if (sc_ < N) *(v2u*)((unsigned char*)wt + (size_t)dr * D + k0 + 8 * c) = o; }
                else { v4u o; o.x = cvt_pk_bf16(p[0], p[65]); o.y = cvt_pk_bf16(p[130], p[195]); o.z = cvt_pk_bf16(p[260], p[325]); o.w = cvt_pk_bf16(p[390], p[455]);
                    if (sc_ < N) *(v4u*)(wt + (size_t)dr * D + k0 + 8 * c) = o; } }
            LDS_WAIT(); asm volatile("" ::: "memory");
            if (has_next) {
#pragma unroll
                for (int i = 0; i < 64; ++i) cur[i] = nxt[i];
                src = nsrc; wt = nwt; N = nN; n0 = nn0; k0 = nk0; mode = nmode; ok = nok; }
        }
#undef TDECODE
    }
    __syncthreads();
    {
        LAS float* sv = (LAS float*)lds;
        for (int i = tid; i < 5 * D; i += NTHR) { const int j = i >> 10, k = i & 1023; const float c = j < 4 ? A.in[I_C][j * D + k] : A.in[I_CCTX][k]; sv[i] = siluf_(c); }
        __syncthreads();
        float* mod = (float*)(ws + WS_MOD);
        LAS float* part = sv + 5 * D;
        for (int it = blockIdx.x; it < DEPTH * 96; it += G) {
            const int l2 = it / 96, n = (it % 96) * 64 + lane, kb = wave * 128;
            const float* w = A.in[I_WMOD] + (size_t)l2 * D * 6144 + (size_t)kb * 6144 + n;
            float a0 = 0.f, a1 = 0.f, a2 = 0.f, a3 = 0.f, a4 = 0.f;
#pragma unroll 16
            for (int k = 0; k < 128; ++k) { const float wv = w[(size_t)k * 6144]; a0 += sv[kb + k] * wv; a1 += sv[1024 + kb + k] * wv; a2 += sv[2048 + kb + k] * wv; a3 += sv[3072 + kb + k] * wv; a4 += sv[4096 + kb + k] * wv; }
            part[(wave * 5 + 0) * 64 + lane] = a0; part[(wave * 5 + 1) * 64 + lane] = a1; part[(wave * 5 + 2) * 64 + lane] = a2; part[(wave * 5 + 3) * 64 + lane] = a3; part[(wave * 5 + 4) * 64 + lane] = a4;
            __syncthreads();
            if (tid < 320) { const int j = tid >> 6, c = tid & 63; float t = 0.f;
#pragma unroll
                for (int w8 = 0; w8 < 8; ++w8) t += part[(w8 * 5 + j) * 64 + c];
                const int nn = (it % 96) * 64 + c;
                mod[((size_t)l2 * 5 + j) * 6144 + nn] = t + A.in[I_BMOD][l2 * 6144 + nn]; }
            __syncthreads();
        }
    }
    __syncthreads();
}

__device__ __forceinline__ void moe_offsets(int l, LAS int* lctl) {
    KArgs& A = get_args();
    __syncthreads();
    const int tid_ = opq_tid();
    if (tid_ < 64) {
        const int e = tid_ & 31;
        const unsigned* cnt = (const unsigned*)(A.ws + WS_CTL) + CW_CNT + l * 32 * 64;
        const int c = (int)__hip_atomic_load(cnt + e * 64, RLX_AGENT);
        const int t = (c + 255) >> 8;
        int incl = t;
#pragma unroll
        for (int o = 1; o < 32; o <<= 1) { const int v = shsrci(incl, (tid_ - o) & 63); if (e >= o) incl += v; }
        if (tid_ < 32) { lctl[e] = incl - t; lctl[64 + e] = c; if (e == 31) lctl[32] = incl;
            for (int k = 0; k < t; ++k) lctl[128 + incl - t + k] = e; }
    }
    __syncthreads();
}

template <int MODE> __device__ __forceinline__ void phase_norm1(int l, LAS unsigned char* lds) {
    KArgs& A = get_args();
    const int tid = opq_tid(), lane = tid & 63, wave = __builtin_amdgcn_readfirstlane(tid >> 6);
    const int G = gridDim.x, gw = blockIdx.x * NWAVES + wave, NGW = G * NWAVES;
    LAS int* lctl = (LAS int*)(lds + LDSCTL_OFF + 256);
    const bool comb = (MODE == 1) || (l > 0);
    const int lp = (MODE == 1) ? (DEPTH - 1) : (l - 1);
    if (comb) moe_offsets(lp, lctl);
    unsigned char* ws = A.ws;
    bf16* X = (bf16*)(ws + WS_X); const float* MOD = (const float*)(ws + WS_MOD);
    const bf16* Y = (const bf16*)(ws + WS_Y); const int* TS = (const int*)(ws + WS_TOKSLOT);
    bf16* HX = (bf16*)(ws + WS_ACT);
    const int mend = (MODE == 1) ? ML : MT;
    for (int m = gw; m < mend; m += NGW) {
        const int b = m < ML ? (m >> 13) : 4;
        f32x4 x[4];
        if (MODE == 0 && !comb) {
            const f32x4* xs = (const f32x4*)(m < ML ? A.in[I_X] + (size_t)m * D : A.in[I_CTX] + (size_t)(m - ML) * D) + lane;
            v2u* orow = (v2u*)(X + (size_t)m * D) + lane;
#pragma unroll
            for (int j = 0; j < 4; ++j) { x[j] = xs[64 * j]; v2u w; w.x = cvt_pk_bf16(x[j][0], x[j][1]); w.y = cvt_pk_bf16(x[j][2], x[j][3]); orow[64 * j] = w; }
        } else {
            const v2u* xr = (const v2u*)(X + (size_t)m * D) + lane;
#pragma unroll
            for (int j = 0; j < 4; ++j) { const v2u xv = xr[64 * j]; x[j] = (f32x4){bflo(xv.x), bfhi(xv.x), bflo(xv.y), bfhi(xv.y)}; }
        }
        if (comb) {
            const float* g2 = MOD + (size_t)(lp * 5 + b) * 6144 + 5 * 1024;
            f32x4 a[4];
#pragma unroll
            for (int j = 0; j < 4; ++j) a[j] = (f32x4){0.f, 0.f, 0.f, 0.f};
#pragma unroll
            for (int k = 0; k < 4; ++k) {
                const int slot = TS[m * 4 + k]; const int e = slot >> 20, rank = slot & 0xfffff;
                const float gt = ((const float*)(ws + WS_ROWGATE))[m * 4 + k] * pg8::YSC_INV;
                const size_t yrow = (size_t)lctl[e] * 256 + rank;
                const unsigned char* yb = (const unsigned char*)Y + ((size_t)(lane >> 4) * pg8::YROWS + yrow) * 64 + (lane & 15) * 4;
#pragma unroll
                for (int j = 0; j < 4; ++j) { const int y = *(const int*)(yb + (size_t)(4 * j) * pg8::YROWS * 64);
                    const auto lo = __builtin_amdgcn_cvt_pk_f32_fp8(y, false), hi = __builtin_amdgcn_cvt_pk_f32_fp8(y, true);
                    a[j][0] += gt * lo[0]; a[j][1] += gt * lo[1]; a[j][2] += gt * hi[0]; a[j][3] += gt * hi[1]; }
            }
#pragma unroll
            for (int j = 0; j < 4; ++j) { const f32x4 gv = *((const f32x4*)g2 + lane + 64 * j);
                x[j] = x[j] + gv * a[j]; }
            if (MODE == 1) { f32x4* orow = (f32x4*)(A.out + (size_t)m * D) + lane;
#pragma unroll
                for (int j = 0; j < 4; ++j) orow[64 * j] = x[j]; }
            else { v2u* orow = (v2u*)(X + (size_t)m * D) + lane;
#pragma unroll
                for (int j = 0; j < 4; ++j) { v2u w; w.x = cvt_pk_bf16(x[j][0], x[j][1]); w.y = cvt_pk_bf16(x[j][2], x[j][3]); orow[64 * j] = w; } }
        }
        if (MODE == 0) {
            float ss = 0.f;
#pragma unroll
            for (int j = 0; j < 4; ++j) ss += (x[j][0] * x[j][0] + x[j][1] * x[j][1]) + (x[j][2] * x[j][2] + x[j][3] * x[j][3]);
            const float r = rsqrtf(wave_sum(ss, lane) * (1.0f / D) + EPS);
            const float* mod = MOD + (size_t)(l * 5 + b) * 6144;
            const f32x4* nw = (const f32x4*)(A.in[I_NMIX] + l * D) + lane;
            unsigned* o = (unsigned*)((unsigned char*)HX + (size_t)m * D) + lane;
#pragma unroll
            for (int j = 0; j < 4; ++j) { const f32x4 w = nw[64 * j], sh = *((const f32x4*)mod + lane + 64 * j), sc = *((const f32x4*)(mod + 1024) + lane + 64 * j);
                const f32x4 y = x[j] * r * w * (sc + 1.0f) + sh;
                o[64 * j] = pg8::pk4_fp8(y[0], y[1], y[2], y[3]); }
        }
    }
}

__device__ __forceinline__ void phase_norm2(int l, LAS unsigned char* lds) {
    KArgs& A = get_args();
    const int tid = opq_tid(), lane = tid & 63, wave = __builtin_amdgcn_readfirstlane(tid >> 6), t = lane & 15, g = lane >> 4;
    const int G = gridDim.x;
    unsigned char* ws = A.ws;
    constexpr int WST = 1032;
    LAS bf16* WH = (LAS bf16*)lds;
    LAS float* A5 = (LAS float*)(lds + 66048);
    LAS float* SH5 = (LAS float*)(lds + 66048 + 20480);
    LAS float* PL = (LAS float*)(lds + 66048 + 40960);
    LAS float* SS = (LAS float*)(lds + 66048 + 40960 + 16384);
    LAS float* C5 = SS + 128;
    LAS int* TE = (LAS int*)(SS + 128 + 160);
    LAS float* TG = (LAS float*)(TE + 576);
    LAS int* TR = TE + 1152;
    LAS int* LCNT = TE + 1728;
    const float* MOD = (const float*)(ws + WS_MOD);
    { const float* rw = A.in[I_RW] + (size_t)l * D * NE;
      for (int i = tid; i < D * NE; i += NTHR) { const int k = i >> 5, e = i & 31; WH[e * WST + k] = f2bf(rw[i]); }
      const float* nw = A.in[I_NFFN] + l * D;
      for (int i = tid; i < 5 * D; i += NTHR) { const int b = i >> 10, k = i & 1023; const float* mod = MOD + (size_t)(l * 5 + b) * 6144 + 3 * 1024;
          A5[i] = nw[k] * (1.0f + mod[1024 + k]); SH5[i] = mod[k]; }
      if (tid < 64) LCNT[tid] = 0; }
    __syncthreads();
    for (int p = wave; p < 160; p += NWAVES) { const int b = p >> 5, e = p & 31; float acc = 0.f;
#pragma unroll
        for (int q = 0; q < 2; ++q) { float w8[8]; unpack8(*(const LAS v4u*)(WH + e * WST + 16 * lane + 8 * q), w8);
            const f32x4 s0 = *(const LAS f32x4*)(SH5 + b * 1024 + 16 * lane + 8 * q), s1 = *(const LAS f32x4*)(SH5 + b * 1024 + 16 * lane + 8 * q + 4);
            acc += (s0[0] * w8[0] + s0[1] * w8[1]) + (s0[2] * w8[2] + s0[3] * w8[3]) + (s1[0] * w8[4] + s1[1] * w8[5]) + (s1[2] * w8[6] + s1[3] * w8[7]); }
        acc = wave_sum(acc, lane);
        if (lane == 0) C5[p] = acc + A.in[I_RB][l * NE + e]; }
    __syncthreads();
    const bf16* X = (const bf16*)(ws + WS_X);
    unsigned char* TOK8 = (unsigned char*)(ws + WS_ACT);
    const int mend = (l == DEPTH - 1) ? ML : MT, ntile = mend >> 4;
    const int kw = wave * 128;
    f32x4 xc[4][2], xn[4][2];
    auto ldx = [&](int T, f32x4 (&d)[4][2]) {
        const bf16* xp = X + (size_t)(16 * T + t) * D + kw + 8 * g;
#pragma unroll
        for (int s2 = 0; s2 < 4; ++s2) { float xl[8]; unpack8(*(const v4u*)(xp + 32 * s2), xl);
            d[s2][0] = (f32x4){xl[0], xl[1], xl[2], xl[3]}; d[s2][1] = (f32x4){xl[4], xl[5], xl[6], xl[7]}; }
    };
    int T = blockIdx.x, it = 0;
    if (T < ntile) ldx(T, xc);
    for (; T < ntile; T += G, ++it) {
        if (T + G < ntile) ldx(T + G, xn);
        const int m0 = 16 * T, b = m0 < ML ? (m0 >> 13) : 4;
        float u[4][8]; float ss = 0.f;
        f32x4 acc[2] = {(f32x4){0.f, 0.f, 0.f, 0.f}, (f32x4){0.f, 0.f, 0.f, 0.f}};
#pragma unroll
        for (int s2 = 0; s2 < 4; ++s2) {
            const int k0 = kw + 32 * s2 + 8 * g;
            const f32x4 a0 = *(const LAS f32x4*)(A5 + b * 1024 + k0), a1 = *(const LAS f32x4*)(A5 + b * 1024 + k0 + 4);
            const f32x4 x0 = xc[s2][0], x1 = xc[s2][1];
            ss += (x0[0] * x0[0] + x0[1] * x0[1]) + (x0[2] * x0[2] + x0[3] * x0[3]) + (x1[0] * x1[0] + x1[1] * x1[1]) + (x1[2] * x1[2] + x1[3] * x1[3]);
#pragma unroll
            for (int j = 0; j < 4; ++j) { u[s2][j] = x0[j] * a0[j]; u[s2][4 + j] = x1[j] * a1[j]; }
            const v4u hi = pack8(u[s2]); float hf[8], lo[8]; unpack8(hi, hf);
#pragma unroll
            for (int j = 0; j < 8; ++j) lo[j] = u[s2][j] - hf[j];
            const bf16x8 fh = as_frag(hi), fl = as_frag(pack8(lo));
#pragma unroll
            for (int et = 0; et < 2; ++et) { const bf16x8 wf = *(const LAS bf16x8*)(WH + (16 * et + t) * WST + k0);
                acc[et] = mfma16(fh, wf, acc[et]); acc[et] = mfma16(fl, wf, acc[et]); }
        }
        ss += shx(ss, 16, lane); ss += shx(ss, 32, lane);
        if (g == 0) SS[wave * 16 + t] = ss;
#pragma unroll
        for (int et = 0; et < 2; ++et)
#pragma unroll
            for (int rg = 0; rg < 4; ++rg) PL[(wave * 16 + 4 * g + rg) * 32 + 16 * et + t] = acc[et][rg];
        __syncthreads();
        {
            float st = 0.f;
#pragma unroll
            for (int w8 = 0; w8 < 8; ++w8) st += SS[w8 * 16 + t];
            const float r = rsqrtf(st * (1.0f / D) + EPS);
            unsigned char* op = TOK8 + (size_t)(m0 + t) * D + kw + 8 * g;
#pragma unroll
            for (int s2 = 0; s2 < 4; ++s2) { const int k0 = kw + 32 * s2 + 8 * g;
                const f32x4 h0 = *(const LAS f32x4*)(SH5 + b * 1024 + k0), h1 = *(const LAS f32x4*)(SH5 + b * 1024 + k0 + 4);
                v2u w; w.x = pg8::pk4_fp8(r * u[s2][0] + h0[0], r * u[s2][1] + h0[1], r * u[s2][2] + h0[2], r * u[s2][3] + h0[3]);
                w.y = pg8::pk4_fp8(r * u[s2][4] + h1[0], r * u[s2][5] + h1[1], r * u[s2][6] + h1[2], r * u[s2][7] + h1[3]);
                *(v2u*)(op + 32 * s2) = w; }
        }
        {
            const int tk = 2 * wave + (lane >> 5), e = lane & 31;
            float st = 0.f, pl = 0.f;
#pragma unroll
            for (int w8 = 0; w8 < 8; ++w8) { st += SS[w8 * 16 + tk]; pl += PL[(w8 * 16 + tk) * 32 + e]; }
            const float logit = rsqrtf(st * (1.0f / D) + EPS) * pl + C5[b * 32 + e];
            unsigned kb = __float_as_uint(logit); kb = (kb & 0x80000000u) ? ~kb : (kb | 0x80000000u);
            unsigned key = (kb & ~31u) | (unsigned)(31 - e);
            float tv[4]; int te[4];
#pragma unroll
            for (int rdx = 0; rdx < 4; ++rdx) {
                unsigned bk = key;
#pragma unroll
                for (int o2 = 1; o2 < 32; o2 <<= 1) { const unsigned ok = (unsigned)shxi((int)bk, o2, lane); bk = ok > bk ? ok : bk; }
                te[rdx] = 31 - (int)(bk & 31u);
                tv[rdx] = shsrc(logit, (lane & 32) | te[rdx]);
                if (e == te[rdx]) key = 0u;
            }
            const float e1 = __expf(tv[1] - tv[0]), e2 = __expf(tv[2] - tv[0]), e3 = __expf(tv[3] - tv[0]);
            const float inv = 1.0f / (1.0f + e1 + e2 + e3);
            if (e < 4) {
                const int ek = e == 0 ? te[0] : (e == 1 ? te[1] : (e == 2 ? te[2] : te[3]));
                const float gk = (e == 0 ? 1.0f : (e == 1 ? e1 : (e == 2 ? e2 : e3))) * inv;
                const int slot = (it * 16 + tk) * 4 + e;
                TE[slot] = ek; TG[slot] = gk; TR[slot] = __hip_atomic_fetch_add(LCNT + ek, 1, __ATOMIC_RELAXED, __HIP_MEMORY_SCOPE_WORKGROUP);
            }
        }
        __syncthreads();
#pragma unroll
        for (int s2 = 0; s2 < 4; ++s2) { xc[s2][0] = xn[s2][0]; xc[s2][1] = xn[s2][1]; }
    }
    __syncthreads();
    if (tid < 32) { unsigned* cnt = (unsigned*)(ws + WS_CTL) + CW_CNT + l * 32 * 64; const int c = LCNT[tid]; LCNT[32 + tid] = c > 0 ? (int)__hip_atomic_fetch_add(cnt + tid * 64, (unsigned)c, RLX_AGENT) : 0; }
    __syncthreads();
    {
        int* ROWTOK = (int*)(ws + WS_ROWTOK); float* ROWGATE = (float*)(ws + WS_ROWGATE); int* TS = (int*)(ws + WS_TOKSLOT);
        for (int q = tid; q < it * 64; q += NTHR) {
            const int rd = q >> 6, tk = (q >> 2) & 15, k = q & 3, m = 16 * (blockIdx.x + rd * G) + tk;
            const int ek = TE[q]; const int rank = LCNT[32 + ek] + TR[q];
            ROWTOK[(size_t)ek * CAP + rank] = m; ROWGATE[m * 4 + k] = TG[q]; TS[m * 4 + k] = (ek << 20) | rank; }
    }
}

__device__ __forceinline__ float incl_prefix_sum(float v, int lane) {
#pragma unroll
    for (int o = 1; o < 64; o <<= 1) { const float t = shsrc(v, (lane - o) & 63); if (lane >= o) v += t; }
    return v;
}
__device__ __forceinline__ float incl_suffix_sum(float v, int lane) {
#pragma unroll
    for (int o = 1; o < 64; o <<= 1) { const float t = shsrc(v, (lane + o) & 63); if (lane + o < 64) v += t; }
    return v;
}
__device__ __forceinline__ float incl_prefix_max(float v, int lane) {
#pragma unroll
    for (int o = 1; o < 64; o <<= 1) { const float t = shsrc(v, (lane - o) & 63); if (lane >= o) v = fmaxf(v, t); }
    return v;
}
__device__ __forceinline__ float incl_suffix_max(float v, int lane) {
#pragma unroll
    for (int o = 1; o < 64; o <<= 1) { const float t = shsrc(v, (lane + o) & 63); if (lane + o < 64) v = fmaxf(v, t); }
    return v;
}
__device__ __forceinline__ float ret_log_gamma(int h, int dir) { const int e = dir + 2 * h; const float t[8] = {-3.174869831e-02f, -1.574835697e-02f, -7.843177461e-03f, -3.913899321e-03f, -1.955034836e-03f, -9.770396478e-04f, -4.884004981e-04f, -2.441704322e-04f};
    float r = t[0];
#pragma unroll
    for (int i = 1; i < 8; ++i) r = (e == i) ? t[i] : r;
    return r; }

__device__ __forceinline__ void store_tr8(bf16* dst  , const unsigned (&w)[8][4]) {
#pragma unroll
    for (int c = 0; c < 8; ++c) *(v4u*)(dst + c * 8) = (v4u){w[c][0], w[c][1], w[c][2], w[c][3]};
}
__device__ __forceinline__ void phase_prepass(int l) {
    KArgs& A = get_args();
    const int tid = opq_tid(), lane = tid & 63, wave = __builtin_amdgcn_readfirstlane(tid >> 6);
    unsigned char* ws = A.ws;
    const bf16* PX = (const bf16*)(ws + WS_PX); const float* ROPE = (const float*)(ws + WS_ROPE);
    bf16* KNH = (bf16*)(ws + WS_KN); bf16* QK2 = (bf16*)(ws + WS_QK2); bf16* VTB = (bf16*)(ws + WS_VTB);
    const int NWI = (MT / 32) * 4 * 2;
    for (int wi = blockIdx.x * NWAVES + wave; wi < NWI; wi += gridDim.x * NWAVES) {
        const int kind = 3 + (wi & 1), ug = wi >> 1, g = ug & 3, u = ug >> 2;
        const int row0 = u * 32;
        int rows[8];
#pragma unroll
        for (int k = 0; k < 8; ++k) rows[k] = row0 + (k < 4 ? 4 * g + k : 16 + 4 * g + (k - 4));
        if (kind == 0) {
            const int hp = lane, part = lane & 7; const float* knw = A.in[I_KNORM] + l * 64 + 8 * part;
            float kw[8];
#pragma unroll
            for (int q = 0; q < 8; ++q) kw[q] = knw[q];
#pragma unroll
            for (int k = 0; k < 8; ++k) { float x[8]; unpack8(*(const v4u*)(PX + pxo(rows[k], C_NK + hp * 8)), x);
                float ss = 0.f;
#pragma unroll
                for (int q = 0; q < 8; ++q) ss += x[q] * x[q];
                ss += shx(ss, 1, lane); ss += shx(ss, 2, lane); ss += shx(ss, 4, lane);
                const float rn = rsqrtf(ss * (1.0f / 64.0f) + EPS);
#pragma unroll
                for (int q = 0; q < 8; ++q) x[q] *= rn * kw[q];
                *(v4u*)(KNH + ((size_t)(hp >> 3) * MT + rows[k]) * 64 + 8 * part) = pack8(x); }
        } else if (kind <= 2) {
            const int cg = (kind - 1) * 64 + lane, ch = cg * 8;
            const int src = ch < 512 ? C_NV + ch : (ch < 768 ? C_MV + (ch - 512) : C_RV + (ch - 768));
            v4u raw[8];
#pragma unroll
            for (int k = 0; k < 8; ++k) raw[k] = *(const v4u*)(PX + pxo(rows[k], src));
            unsigned w[8][4];
#pragma unroll
            for (int c = 0; c < 8; ++c)
#pragma unroll
                for (int q = 0; q < 4; ++q) { const unsigned lo = raw[2 * q][c >> 1], hi = raw[2 * q + 1][c >> 1];
                    w[c][q] = (c & 1) ? __builtin_amdgcn_perm(hi, lo, 0x07060302u) : __builtin_amdgcn_perm(hi, lo, 0x05040100u); }
            store_tr8(VTB + ((((size_t)u * VTB_H + (ch >> 6)) * 4 + g) * 64 + (ch & 63)) * 8, w);
        } else {
            const bool isk = lane >= 32; const int cg = lane & 31, hh = cg >> 3, part = cg & 7;
            const float sc = isk ? 0.125f : 1.0f;
            float o[8][8];
            if (kind == 3) {
                const int ch = (isk ? 256 : 0) + cg * 8;
                const float* cw = A.in[I_CONVW] + (size_t)l * 3 * 512 + ch; const float* cb = A.in[I_CONVB] + l * 512 + ch;
                float w0[8], w1[8], w2[8], bb[8];
#pragma unroll
                for (int q = 0; q < 8; ++q) { w0[q] = cw[q]; w1[q] = cw[512 + q]; w2[q] = cw[1024 + q]; bb[q] = cb[q]; }
#pragma unroll
                for (int half = 0; half < 2; ++half) {
                    const int r0 = row0 + 16 * half + 4 * g;
                    const int ts0 = r0 < ML ? (r0 & (SEQ - 1)) : ((r0 - ML) & (CTXL - 1)), slen = r0 < ML ? SEQ : CTXL;
                    float x[6][8];
#pragma unroll
                    for (int k = 0; k < 6; ++k) { const int ts = ts0 + k - 1;
                        if (ts >= 0 && ts < slen) unpack8(*(const v4u*)(PX + pxo(r0 + k - 1, C_MQ + ch)), x[k]); else {
#pragma unroll
                            for (int q = 0; q < 8; ++q) x[k][q] = 0.f; } }
#pragma unroll
                    for (int k = 0; k < 4; ++k)
#pragma unroll
                        for (int q = 0; q < 8; ++q) o[4 * half + k][q] = siluf_(bb[q] + w0[q] * x[k][q] + w1[q] * x[k + 1][q] + w2[q] * x[k + 2][q]) * sc;
                }
            } else {
                if (isk) {
#pragma unroll
                    for (int k = 0; k < 8; ++k) unpack8f8(*(const v2u*)((const unsigned char*)QK2 + ((size_t)(12 + hh) * MT + rows[k]) * 64 + 8 * part), o[k], QSC_INV);
                }
            }
            const int slot = (kind == 3 ? 0 : 8) + (isk ? 4 : 0) + hh;
#pragma unroll
            for (int k = 0; k < 8 && kind == 3; ++k) { v2u w8; w8.x = pg8::pk4_fp8(o[k][0] * QSC, o[k][1] * QSC, o[k][2] * QSC, o[k][3] * QSC); w8.y = pg8::pk4_fp8(o[k][4] * QSC, o[k][5] * QSC, o[k][6] * QSC, o[k][7] * QSC);
                *(v2u*)((unsigned char*)QK2 + ((size_t)slot * MT + rows[k]) * 64 + 8 * part) = w8; }
            if (isk) { unsigned char* vt = ws + WS_VTK8 + ((((size_t)u * 8 + (kind == 3 ? 0 : 4) + hh) * 4 + g) * 64 + 8 * part) * 8;
#pragma unroll
                for (int c = 0; c < 8; ++c) { v2u w8; w8.x = pg8::pk4_fp8(o[0][c] * QSC, o[1][c] * QSC, o[2][c] * QSC, o[3][c] * QSC); w8.y = pg8::pk4_fp8(o[4][c] * QSC, o[5][c] * QSC, o[6][c] * QSC, o[7][c] * QSC);
                    *(v2u*)(vt + c * 8) = w8; } }
        }
    }
}

template <int TYPE> __device__ __forceinline__ void unit_stats2(int l, LAS unsigned char* lds, int b, int cc, int h) {
    KArgs& A = get_args();
    const int tid = opq_tid(), lane = tid & 63, wave = __builtin_amdgcn_readfirstlane(tid >> 6), fr = lane & 15, g = lane >> 4;
    unsigned char* ws = A.ws;
    const bf16* PX = (const bf16*)(ws + WS_PX); const bf16* VTB = (const bf16*)(ws + WS_VTB);
    LAS float* EW = (LAS float*)(lds + wave * 512);
    const int row0 = chunk_row(b, cc), seq0 = (b * 4 + h) * 2, blk0 = row0 >> 5;
    float* MLOC = (float*)(ws + WS_MISC); float* BTOT = MLOC + NSEQ * NCH;
    if (TYPE == 0) {
        const bf16* gp = PX + pxo(row0 + lane, C_GATE); const float* gb = A.in[I_GATEB] + l * 16;
#pragma unroll
        for (int dir = 0; dir < 2; ++dir) {
            const float li = bf2f(gp[dir * 8 + h]) + gb[dir * 8 + h];
            const float lf = logsigmoidf_(bf2f(gp[dir * 8 + 4 + h]) + gb[dir * 8 + 4 + h]);
            const float cum = dir == 0 ? incl_prefix_sum(lf, lane) : incl_suffix_sum(lf, lane);
            const float btot = shsrc(cum, dir == 0 ? 63 : 0);
            const float wl = btot - cum + li;
            const float ml = wave_max(wl, lane);
            EW[dir * 64 + lane] = __expf(wl - ml);
            if (lane == 0) { MLOC[(seq0 + dir) * NCH + cc] = ml; BTOT[(seq0 + dir) * NCH + cc] = btot; }
        }
    } else {
#pragma unroll
        for (int dir = 0; dir < 2; ++dir) EW[dir * 64 + lane] = __expf(ret_log_gamma(h, dir) * (float)(dir == 0 ? 63 - lane : lane));
    }
    bf16x8 vf[2][4];
#pragma unroll
    for (int ks = 0; ks < 2; ++ks)
#pragma unroll
        for (int et = 0; et < 4; ++et) vf[ks][et] = as_frag(*(const v4u*)(VTB + ((((size_t)(blk0 + ks) * VTB_H + 8 + 4 * TYPE + h) * 4 + g) * 64 + 16 * et + fr) * 8));
    v2u kraw[2][4];
#pragma unroll
    for (int ks = 0; ks < 2; ++ks)
#pragma unroll
        for (int dt = 0; dt < 4; ++dt) kraw[ks][dt] = *(const v2u*)(ws + WS_VTK8 + ((((size_t)(blk0 + ks) * 8 + 4 * TYPE + h) * 4 + g) * 64 + 16 * dt + fr) * 8);
#pragma unroll
    for (int dir = 0; dir < 2; ++dir) {
        f32x4 acc[4][4];
#pragma unroll
        for (int et = 0; et < 4; ++et)
#pragma unroll
            for (int dt = 0; dt < 4; ++dt) acc[et][dt] = (f32x4){0.f, 0.f, 0.f, 0.f};
        float nsum[4] = {0.f, 0.f, 0.f, 0.f};
#pragma unroll
        for (int ks = 0; ks < 2; ++ks) {
            const f32x4 e0 = *(const LAS f32x4*)(EW + dir * 64 + 32 * ks + 4 * g), e1 = *(const LAS f32x4*)(EW + dir * 64 + 32 * ks + 16 + 4 * g);
            const float ew[8] = {e0[0], e0[1], e0[2], e0[3], e1[0], e1[1], e1[2], e1[3]};
#pragma unroll
            for (int dt = 0; dt < 4; ++dt) { float k[8]; unpack8f8(kraw[ks][dt], k, QSC_INV);
#pragma unroll
                for (int i = 0; i < 8; ++i) k[i] *= ew[i];
                const v4u pk = pack8(k); const bf16x8 kfr = as_frag(pk);
                if (TYPE == 0) { float kr[8]; unpack8(pk, kr); nsum[dt] += ((kr[0] + kr[1]) + (kr[2] + kr[3])) + ((kr[4] + kr[5]) + (kr[6] + kr[7])); }
#pragma unroll
                for (int et = 0; et < 4; ++et) acc[et][dt] = mfma16(vf[ks][et], kfr, acc[et][dt]); }
        }
        float* CL = (float*)(ws + (TYPE == 0 ? WS_CLOC : WS_RLOC)) + ((size_t)(seq0 + dir) * NCH + cc) * 4096;
#pragma unroll
        for (int et = 0; et < 4; ++et)
#pragma unroll
            for (int dt = 0; dt < 4; ++dt)
#pragma unroll
                for (int r = 0; r < 4; ++r) CL[(16 * et + 4 * g + r) * 64 + 16 * dt + fr] = acc[et][dt][r];
        if (TYPE == 0) {
#pragma unroll
            for (int dt = 0; dt < 4; ++dt) { float n = nsum[dt]; n += shx(n, 16, lane); n += shx(n, 32, lane);
                if (g == 0) ((float*)(ws + WS_NLOC))[((size_t)(seq0 + dir) * NCH + cc) * 64 + 16 * dt + fr] = n; }
        }
    }
}

#define NA_LOADSTEP(st, KF, VF) do { const int _t0 = (st) < nloc ? b * SEQ + (rs + ((st) >> 1)) * 64 + 32 * ((st) & 1) : ML + b * CTXL + 32 * ((st) - nloc); \
    _Pragma("unroll") for (int _t = 0; _t < 2; ++_t) _Pragma("unroll") for (int _s = 0; _s < 2; ++_s) KF[_t][_s] = *(const v4u*)(KN + ((size_t)h * MT + _t0 + 16 * _t + fr) * 64 + 32 * _s + 8 * g); \
    _Pragma("unroll") for (int _e = 0; _e < 4; ++_e) VF[_e] = *(const v4u*)(VTB + ((((size_t)(_t0 >> 5) * VTB_H + h) * 4 + g) * 64 + 16 * _e + fr) * 8); } while (0)
__device__ __forceinline__ void unit_na2(int l, LAS unsigned char* lds, int b, int r, int h, bool ctxq) {
    KArgs& A = get_args();
    const int tid = opq_tid(), lane = tid & 63, wave = __builtin_amdgcn_readfirstlane(tid >> 6), fr = lane & 15, g = lane >> 4;
    unsigned char* ws = A.ws;
    const bf16* PX = (const bf16*)(ws + WS_PX); const bf16* KN = (const bf16*)(ws + WS_KN); const bf16* VTB = (const bf16*)(ws + WS_VTB);
    LAS float* RPB = (LAS float*)(lds + wave * 6144) + 128;
    const int qrow0 = ctxq ? ML + b * CTXL + r * 64 : b * SEQ + r * 64;
    const int nloc = ctxq ? 0 : 16, nsteps = nloc + 8;
    const int rs = r - 4 < 0 ? 0 : (r - 4 > 120 ? 120 : r - 4);
    constexpr float LOG2E = 1.4426950408889634f;
    float bmax = 0.f;
    if (!ctxq) { const float* rp = A.in[I_RPB] + ((size_t)l * 8 + h) * 465; for (int i = lane; i < 465; i += 64) { const float t = rp[i] * LOG2E; RPB[i] = t; bmax = fmaxf(bmax, fabsf(t)); } bmax = wave_max(bmax, lane); }
    const float knmax = wave_max(fabsf(A.in[I_KNORM][l * 64 + lane]), lane) * 8.0f;
    bf16x8 qf[4][2]; float nm[4];
    {
        const float* qn = A.in[I_QNORM] + l * 64;
#pragma unroll
        for (int qt = 0; qt < 4; ++qt) {
            float q[2][8]; float ss = 0.f;
#pragma unroll
            for (int s = 0; s < 2; ++s) { unpack8(*(const v4u*)(PX + pxo(qrow0 + 16 * qt + fr, C_NQ + h * 64 + 32 * s + 8 * g)), q[s]);
#pragma unroll
                for (int i = 0; i < 8; ++i) ss += q[s][i] * q[s][i]; }
            ss += shx(ss, 16, lane); ss += shx(ss, 32, lane);
            const float rn = rsqrtf(ss * (1.0f / 64.0f) + EPS) * (0.125f * LOG2E);
            float s2 = 0.f;
#pragma unroll
            for (int s = 0; s < 2; ++s) {
#pragma unroll
                for (int i = 0; i < 8; ++i) { q[s][i] *= rn * qn[32 * s + 8 * g + i]; s2 += q[s][i] * q[s][i]; }
                qf[qt][s] = as_frag(pack8(q[s])); }
            s2 += shx(s2, 16, lane); s2 += shx(s2, 32, lane);
            nm[qt] = -(sqrtf(s2) * knmax * 1.01f + bmax);
        }
    }
    float ls[4]; f32x4 OT[4][4];
#pragma unroll
    for (int qt = 0; qt < 4; ++qt) { ls[qt] = 0.f;
#pragma unroll
        for (int et = 0; et < 4; ++et) OT[qt][et] = (f32x4){0.f, 0.f, 0.f, 0.f}; }
    v4u kc_[2][2], vc_[4], kn_[2][2], vn_[4];
    NA_LOADSTEP(0, kc_, vc_);
    for (int st = 0; st < nsteps; ++st) {
        if (st + 1 < nsteps) NA_LOADSTEP(st + 1, kn_, vn_);
        const bool local = st < nloc;
        const int hh = st & 1, dr = rs + (st >> 1) - r + 7;
#pragma unroll
        for (int qt = 0; qt < 4; ++qt) {
            const bool act = !local || (hh == 0 ? qt <= 2 : qt >= 1);
            if (act) {
                f32x4 sT[2];
                const f32x4 init = (f32x4){nm[qt], nm[qt], nm[qt], nm[qt]};
                const bool dead0 = local && qt == 2 && hh == 0, dead1 = local && qt == 1 && hh == 1;
#pragma unroll
                for (int t = 0; t < 2; ++t) { if ((t == 0 && dead0) || (t == 1 && dead1)) continue; sT[t] = mfma16(as_frag(kc_[t][0]), qf[qt][0], init); sT[t] = mfma16(as_frag(kc_[t][1]), qf[qt][1], sT[t]); }
                float p[8];
                if (local) {
                    const int qc = 16 * qt + fr; const int cs = qc - 8 < 0 ? 0 : (qc - 8 > 48 ? 48 : qc - 8);
                    const int kc0 = 32 * hh + 4 * g;
                    const LAS float* bp = RPB + dr * 31 + (kc0 - qc + 15);
                    const int d0 = kc0 - cs;
                    float bia[8];
#pragma unroll
                    for (int t = 0; t < 2; ++t)
#pragma unroll
                        for (int rg = 0; rg < 4; ++rg) bia[4 * t + rg] = bp[16 * t + rg];
                    asm volatile("" : "+v"(bia[0]), "+v"(bia[1]), "+v"(bia[2]), "+v"(bia[3]), "+v"(bia[4]), "+v"(bia[5]), "+v"(bia[6]), "+v"(bia[7]));
#pragma unroll
                    for (int t = 0; t < 2; ++t) {
                        if ((t == 0 && dead0) || (t == 1 && dead1)) {
#pragma unroll
                            for (int rg = 0; rg < 4; ++rg) p[4 * t + rg] = 0.f;
                        } else {
#pragma unroll
                            for (int rg = 0; rg < 4; ++rg) { const bool valid = (unsigned)(d0 + 16 * t + rg) < 16u;
                                p[4 * t + rg] = valid ? __builtin_amdgcn_exp2f(sT[t][rg] + bia[4 * t + rg]) : 0.f; }
                        }
                    }
                } else {
#pragma unroll
                    for (int t = 0; t < 2; ++t)
#pragma unroll
                        for (int rg = 0; rg < 4; ++rg) p[4 * t + rg] = __builtin_amdgcn_exp2f(sT[t][rg]);
                }
                ls[qt] += ((p[0] + p[1]) + (p[2] + p[3])) + ((p[4] + p[5]) + (p[6] + p[7]));
                const bf16x8 pf = as_frag(pack8(p));
#pragma unroll
                for (int et = 0; et < 4; ++et) OT[qt][et] = mfma16(as_frag(vc_[et]), pf, OT[qt][et]);
            }
        }
#pragma unroll
        for (int t = 0; t < 2; ++t)
#pragma unroll
            for (int s = 0; s < 2; ++s) kc_[t][s] = kn_[t][s];
#pragma unroll
        for (int e = 0; e < 4; ++e) vc_[e] = vn_[e];
    }
    bf16* MIX = (bf16*)(ws + WS_MIX);
#pragma unroll
    for (int qt = 0; qt < 4; ++qt) {
        float s = ls[qt]; s += shx(s, 16, lane); s += shx(s, 32, lane);
        const float inv = 1.0f / s;
        unsigned char* op = (unsigned char*)MIX + (size_t)(qrow0 + 16 * qt + fr) * D + 256 + h * 64 + 4 * g;
#pragma unroll
        for (int et = 0; et < 4; ++et) { const f32x4 o = OT[qt][et] * inv; *(unsigned*)(op + 16 * et) = pg8::pk4_fp8(o[0], o[1], o[2], o[3]); }
    }
}

__device__ __forceinline__ void phase_stats(int l, LAS unsigned char* lds) {
    const int wave_ = __builtin_amdgcn_readfirstlane(opq_tid() >> 6);
    for (int v = blockIdx.x * NWAVES + wave_; v < 2 * NB * NCH * 4; v += gridDim.x * NWAVES) {
        const int ty = v / (NB * NCH * 4), r = v % (NB * NCH * 4), h = r & 3, cc = (r >> 2) % NCH, b = (r >> 2) / NCH;
        if (ty == 0) unit_stats2<0>(l, lds, b, cc, h); else unit_stats2<1>(l, lds, b, cc, h);
    }
}

__device__ __forceinline__ int chain_cc(int dir, int p) { return dir ? (p < 4 ? 3 - p : 135 - p) : p; }
constexpr int NA_EARLY = 1024;
__device__ __forceinline__ void unit_na2(int l, LAS unsigned char* lds, int b, int r, int h, bool ctxq);
__device__ __forceinline__ void phase_scan(int l, LAS unsigned char* lds) {
    KArgs& A = get_args();
    unsigned char* ws = A.ws;
    const int tid = opq_tid(), wave = __builtin_amdgcn_readfirstlane(tid >> 6);
    if (wave >= 4) {
        const int v = vcu_of((int)blockIdx.x, (int)gridDim.x) * 4 + (wave - 4);
        if (gridDim.x * 4 == NA_EARLY) unit_na2(l, lds, v >> 10, (v >> 3) & 127, v & 7, false);
        return;
    }
    const float* MLOC = (const float*)(ws + WS_MISC); const float* BTOT = MLOC + NSEQ * NCH; float* MPREV = (float*)(ws + WS_MISC) + 2 * NSEQ * NCH;
    const float* CL = (const float*)(ws + WS_CLOC); bf16* CP = (bf16*)(ws + WS_CPREV);
    const float* RL = (const float*)(ws + WS_RLOC); bf16* RP = (bf16*)(ws + WS_RPREV);
    const float* NL = (const float*)(ws + WS_NLOC); float* NP = (float*)(ws + WS_NPREV);
    const int HT = gridDim.x * 256;
    for (int idx0 = blockIdx.x * 256 + tid; idx0 < NSEQ * 4096; idx0 += 2 * HT) {
        int seq[2], el[2], dir[2]; float gch[2], C[2], R[2], m[2], n[2]; size_t base[2]; bool on[2], hasn[2];
#pragma unroll
        for (int c = 0; c < 2; ++c) { const int idx = idx0 + c * HT; on[c] = idx < NSEQ * 4096; const int ii = on[c] ? idx : idx0;
            seq[c] = ii >> 12; el[c] = ii & 4095; dir[c] = seq[c] & 1; gch[c] = __expf(64.0f * ret_log_gamma((seq[c] >> 1) & 3, dir[c]));
            C[c] = 0.f; R[c] = 0.f; m[c] = 0.f; n[c] = 0.f; base[c] = (size_t)seq[c] * NCH * 4096 + el[c]; hasn[c] = el[c] < 64; }
        for (int p0 = 0; p0 < NCH; p0 += 6) {
            float cl[2][6], rl[2][6], ml[2][6], bt[2][6], nl[2][6];
#pragma unroll
            for (int c = 0; c < 2; ++c)
#pragma unroll
                for (int q = 0; q < 6; ++q) { const int cc = chain_cc(dir[c], p0 + q); cl[c][q] = CL[base[c] + (size_t)cc * 4096]; rl[c][q] = RL[base[c] + (size_t)cc * 4096];
                    ml[c][q] = MLOC[seq[c] * NCH + cc]; bt[c][q] = BTOT[seq[c] * NCH + cc]; nl[c][q] = hasn[c] ? NL[((size_t)seq[c] * NCH + cc) * 64 + el[c]] : 0.f; }
#pragma unroll
            for (int c = 0; c < 2; ++c)
#pragma unroll
                for (int q = 0; q < 6; ++q) { const int cc = chain_cc(dir[c], p0 + q); const size_t o = base[c] + (size_t)cc * 4096;
                    if (on[c]) { CP[o] = f2bf(C[c]); RP[o] = f2bf(R[c]);
                        if (hasn[c]) NP[((size_t)seq[c] * NCH + cc) * 64 + el[c]] = n[c];
                        if (el[c] == 0) MPREV[seq[c] * NCH + cc] = m[c]; }
                    const float mn = fmaxf(bt[c][q] + m[c], ml[c][q]), a = __expf(bt[c][q] + m[c] - mn), g = __expf(ml[c][q] - mn);
                    C[c] = a * C[c] + g * cl[c][q]; n[c] = a * n[c] + g * nl[c][q]; m[c] = mn; R[c] = gch[c] * R[c] + rl[c][q]; }
        }
    }
}

template <int TYPE> __device__ __forceinline__ void unit_out2(int l, LAS unsigned char* lds, int b, int cc, int h) {
    KArgs& A = get_args();
    const int tid = opq_tid(), lane = tid & 63, wave = __builtin_amdgcn_readfirstlane(tid >> 6), fr = lane & 15, g = lane >> 4;
    unsigned char* ws = A.ws;
    const bf16* PX = (const bf16*)(ws + WS_PX); const bf16* QK2 = (const bf16*)(ws + WS_QK2); const bf16* VTB = (const bf16*)(ws + WS_VTB);
    LAS float* VEC = (LAS float*)(lds + wave * 6144 + 4096);
    const int row0 = chunk_row(b, cc), seq0 = (b * 4 + h) * 2;
    float mprev[2] = {0.f, 0.f};
    if (TYPE == 0) {
        const bf16* gp = PX + pxo(row0 + lane, C_GATE); const float* gb = A.in[I_GATEB] + l * 16;
#pragma unroll
        for (int dir = 0; dir < 2; ++dir) {
            const float li = bf2f(gp[dir * 8 + h]) + gb[dir * 8 + h];
            const float lf = logsigmoidf_(bf2f(gp[dir * 8 + 4 + h]) + gb[dir * 8 + 4 + h]);
            const float cum = dir == 0 ? incl_prefix_sum(lf, lane) : incl_suffix_sum(lf, lane);
            const float u = li - cum;
            const float pm = dir == 0 ? incl_prefix_max(u, lane) : incl_suffix_max(u, lane);
            VEC[(dir * 3 + 0) * 64 + lane] = cum; VEC[(dir * 3 + 1) * 64 + lane] = u; VEC[(dir * 3 + 2) * 64 + lane] = pm;
            mprev[dir] = ((const float*)(ws + WS_MISC))[2 * NSEQ * NCH + (seq0 + dir) * NCH + cc];
        }
    }
    bf16x8 kf[4][2];
#pragma unroll
    for (int lt = 0; lt < 4; ++lt)
#pragma unroll
        for (int s = 0; s < 2; ++s) { float kk[8]; unpack8f8(*(const v2u*)((const unsigned char*)QK2 + ((size_t)(8 * TYPE + 4 + h) * MT + row0 + 16 * lt + fr) * 64 + 32 * s + 8 * g), kk, QSC_INV); kf[lt][s] = as_frag(pack8(kk)); }
    bf16x8 vf[2][4];
    { const int hh = (TYPE == 0 ? 8 : 12) + h;
#pragma unroll
      for (int ks = 0; ks < 2; ++ks)
#pragma unroll
        for (int et = 0; et < 4; ++et) vf[ks][et] = as_frag(*(const v4u*)(VTB + ((((size_t)((row0 >> 5) + ks) * VTB_H + hh) * 4 + g) * 64 + 16 * et + fr) * 8)); }
    const float* nw = A.in[TYPE == 0 ? I_MNORM : I_RNORM] + l * 64;
    bf16* MIX = (bf16*)(ws + WS_MIX);
#pragma unroll 1
    for (int jt = 0; jt < 4; ++jt) {
        const int j = 16 * jt + fr;
        bf16x8 qf[2]; float qnp[2] = {0.f, 0.f};
#pragma unroll
        for (int s = 0; s < 2; ++s) { float qr[8]; unpack8f8(*(const v2u*)((const unsigned char*)QK2 + ((size_t)(8 * TYPE + h) * MT + row0 + j) * 64 + 32 * s + 8 * g), qr, QSC_INV); qf[s] = as_frag(pack8(qr));
            if (TYPE == 0) {
#pragma unroll
                for (int dir = 0; dir < 2; ++dir) { const float* np_ = (const float*)(ws + WS_NPREV) + ((size_t)(seq0 + dir) * NCH + cc) * 64 + 32 * s + 8 * g;
                    const f32x4 n0 = *(const f32x4*)np_, n1 = *(const f32x4*)(np_ + 4);
                    qnp[dir] += (qr[0] * n0[0] + qr[1] * n0[1]) + (qr[2] * n0[2] + qr[3] * n0[3]) + (qr[4] * n1[0] + qr[5] * n1[1]) + (qr[6] * n1[2] + qr[7] * n1[3]); } }
        }
        f32x4 hs[4];
#pragma unroll
        for (int et = 0; et < 4; ++et) hs[et] = (f32x4){0.f, 0.f, 0.f, 0.f};
#pragma unroll
        for (int dir = 0; dir < 2; ++dir) {
            const float lg = ret_log_gamma(h, dir);
            float cj = 0.f, mq = 0.f, aw;
            if (TYPE == 0) { cj = VEC[(dir * 3 + 0) * 64 + j]; const float il = cj + mprev[dir]; mq = fmaxf(cj + VEC[(dir * 3 + 2) * 64 + j], il); aw = __expf(il - mq); }
            else aw = __expf(lg * (float)(dir == 0 ? j + 1 : 64 - j));
            float sw[4][4]; float den = 0.f;
#pragma unroll
            for (int lt = 0; lt < 4; ++lt) {
                const bool act = dir == 0 ? (lt <= jt) : (lt >= jt);
                if (act) {
                    f32x4 sT = mfma16(kf[lt][0], qf[0], (f32x4){0.f, 0.f, 0.f, 0.f}); sT = mfma16(kf[lt][1], qf[1], sT);
                    f32x4 uv = (f32x4){0.f, 0.f, 0.f, 0.f};
                    if (TYPE == 0) uv = *(const LAS f32x4*)(VEC + (dir * 3 + 1) * 64 + 16 * lt + 4 * g);
#pragma unroll
                    for (int rg = 0; rg < 4; ++rg) { const int lk = 16 * lt + 4 * g + rg;
                        const bool valid = dir == 0 ? (lk <= j) : (lk >= j);
                        const float w = TYPE == 0 ? __expf(cj + uv[rg] - mq) : __expf(lg * (float)(dir == 0 ? j - lk : lk - j));
                        const float sv = valid ? sT[rg] * w : 0.f;
                        den += sv; sw[lt][rg] = sv; }
                } else {
#pragma unroll
                    for (int rg = 0; rg < 4; ++rg) sw[lt][rg] = 0.f;
                }
            }
            f32x4 accS[4], accI[4];
#pragma unroll
            for (int et = 0; et < 4; ++et) { accS[et] = (f32x4){0.f, 0.f, 0.f, 0.f}; accI[et] = (f32x4){0.f, 0.f, 0.f, 0.f}; }
#pragma unroll
            for (int ks = 0; ks < 2; ++ks) {
                const bool act = dir == 0 ? (2 * ks <= jt) : (2 * ks + 1 >= jt);
                if (act) { float p[8];
#pragma unroll
                    for (int i = 0; i < 4; ++i) { p[i] = sw[2 * ks][i]; p[4 + i] = sw[2 * ks + 1][i]; }
                    const bf16x8 pf = as_frag(pack8(p));
#pragma unroll
                    for (int et = 0; et < 4; ++et) accS[et] = mfma16(vf[ks][et], pf, accS[et]); }
            }
            const bf16* CP = (const bf16*)(ws + (TYPE == 0 ? WS_CPREV : WS_RPREV)) + ((size_t)(seq0 + dir) * NCH + cc) * 4096;
#pragma unroll
            for (int et = 0; et < 4; ++et)
#pragma unroll
                for (int s = 0; s < 2; ++s) { const bf16x8 cf = as_frag(*(const v4u*)(CP + (16 * et + fr) * 64 + 32 * s + 8 * g)); accI[et] = mfma16(cf, qf[s], accI[et]); }
            if (TYPE == 0) {
                den += shx(den, 16, lane); den += shx(den, 32, lane);
                float qn = qnp[dir]; qn += shx(qn, 16, lane); qn += shx(qn, 32, lane);
                const float dd = aw * qn + den;
                const float dn = 1.0f / fmaxf(fabsf(dd), __expf(-mq));
#pragma unroll
                for (int et = 0; et < 4; ++et) hs[et] = hs[et] + (accI[et] * aw + accS[et]) * dn;
            } else {
#pragma unroll
                for (int et = 0; et < 4; ++et) hs[et] = hs[et] + accS[et] + accI[et] * aw;
            }
        }
        float ss = 0.f;
#pragma unroll
        for (int et = 0; et < 4; ++et) ss += (hs[et][0] * hs[et][0] + hs[et][1] * hs[et][1]) + (hs[et][2] * hs[et][2] + hs[et][3] * hs[et][3]);
        ss += shx(ss, 16, lane); ss += shx(ss, 32, lane);
        const float rn = rsqrtf(ss * (1.0f / 64.0f) + EPS);
        const unsigned char* gp2 = ws + WS_DLT + ((size_t)((TYPE == 0 ? 0 : 4) + h) * MT + row0 + j) * 64 + 4 * g;
        unsigned char* op = (unsigned char*)MIX + (size_t)(row0 + j) * D + (TYPE == 0 ? 0 : 768) + h * 64 + 4 * g;
#pragma unroll
        for (int et = 0; et < 4; ++et) {
            const int gr = *(const int*)(gp2 + 16 * et); const f32x4 nv = *(const f32x4*)(nw + 16 * et + 4 * g);
            const auto g01 = __builtin_amdgcn_cvt_pk_f32_fp8(gr, false), g23 = __builtin_amdgcn_cvt_pk_f32_fp8(gr, true);
            const float gz[4] = {g01[0] * GSC_INV, g01[1] * GSC_INV, g23[0] * GSC_INV, g23[1] * GSC_INV};
            float o[4];
#pragma unroll
            for (int i = 0; i < 4; ++i) o[i] = hs[et][i] * rn * nv[i] * (TYPE == 0 ? sigmoidf_(gz[i]) : siluf_(gz[i]));
            *(unsigned*)(op + 16 * et) = pg8::pk4_fp8(o[0], o[1], o[2], o[3]);
        }
    }
}

__device__ __forceinline__ void mix_unit(int l, LAS unsigned char* lds, int v, bool cout_) {
    constexpr int N_NA = NB * 128 * 8, N_NAC = NB * 4 * 8, N_U2 = NB * NCH * 4;
    if (v < N_NA) { unit_na2(l, lds, v >> 10, (v >> 3) & 127, v & 7, false); return; }
    int w = v - N_NA;
    if (w < N_NAC) { if (cout_) unit_na2(l, lds, w >> 5, (w >> 3) & 3, w & 7, true); return; }
    w -= N_NAC;
    const int ty = w / N_U2, r2 = w % N_U2, h = r2 & 3, cc = (r2 >> 2) % NCH, b = (r2 >> 2) / NCH;
    if (cc < 4 && !cout_) return;
    if (ty == 0) unit_out2<0>(l, lds, b, cc, h); else unit_out2<1>(l, lds, b, cc, h);
}
__device__ __forceinline__ void phase_mixout(int l, LAS unsigned char* lds) {
    const int G = gridDim.x;
    const bool cout_ = l < DEPTH - 1;
    constexpr int N_NA = NB * 128 * 8, N_NAC = NB * 4 * 8, N_U2 = NB * NCH * 4, N_ALL = N_NA + N_NAC + 2 * N_U2;
    const int wave_ = __builtin_amdgcn_readfirstlane(opq_tid() >> 6), gw = vcu_of((int)blockIdx.x, G) * NWAVES + wave_, NW = G * NWAVES;
    if (NW == 2048 && G * 4 == NA_EARLY) {
        mix_unit(l, lds, NA_EARLY + gw, cout_);
        if (gw < 1024) mix_unit(l, lds, NA_EARLY + 2048 + gw, cout_);
        else { mix_unit(l, lds, N_NA + (gw - 1024), cout_); mix_unit(l, lds, N_NA + 1024 + (gw - 1024), cout_); }
        for (int v = N_NA + 2048 + gw; v < N_ALL; v += 2048) mix_unit(l, lds, v, cout_);
    } else {
        for (int v = gw; v < N_ALL; v += NW) mix_unit(l, lds, v, cout_);
    }
}

constexpr int N_PHASES = 2 + 10 * DEPTH;
__device__ __forceinline__ void outproj_ctx(int l) {
    KArgs& A = get_args();
    const int tid = opq_tid(), lane = tid & 63, wave = __builtin_amdgcn_readfirstlane(tid >> 6), fr = lane & 15, fq = lane >> 4;
    unsigned char* ws = A.ws;
    const unsigned char* MIX8 = ws + WS_MIX; const unsigned char* W = ws + WS_WOUT + (size_t)l * D * D;
    bf16* X = (bf16*)(ws + WS_X); const float* g1 = (const float*)(ws + WS_MOD) + (size_t)l * 5 * 6144 + 2 * 1024 + 4 * 6144;
    const int f8scale = 0x7f7f7f7f;
    for (int mu = blockIdx.x; mu < 256; mu += gridDim.x) {
        const int rg = mu >> 2, ct = mu & 3;
        const int row = ML + rg * 16 + fr, c0 = ct * 256 + wave * 32;
        const unsigned char* ap = MIX8 + (size_t)row * D + 32 * fq;
        const unsigned char* bp0 = W + (size_t)(c0 + fr) * D + 32 * fq; const unsigned char* bp1 = bp0 + (size_t)16 * D;
        f32x4 acc0 = (f32x4){0.f, 0.f, 0.f, 0.f}, acc1 = (f32x4){0.f, 0.f, 0.f, 0.f};
#pragma unroll
        for (int t = 0; t < 8; ++t) {
            const pg8::v8i_t a = *(const pg8::v8i_t*)(ap + 128 * t), b0 = *(const pg8::v8i_t*)(bp0 + 128 * t), b1 = *(const pg8::v8i_t*)(bp1 + 128 * t);
            asm volatile("v_mfma_scale_f32_16x16x128_f8f6f4 %0, %1, %2, %0, %3, %3 op_sel_hi:[0,0,0]" : "+v"(acc0) : "v"(b0), "v"(a), "v"(f8scale));
            asm volatile("v_mfma_scale_f32_16x16x128_f8f6f4 %0, %1, %2, %0, %3, %3 op_sel_hi:[0,0,0]" : "+v"(acc1) : "v"(b1), "v"(a), "v"(f8scale));
        }
        asm volatile("s_nop 15\n\ts_nop 15" ::: "memory");
#pragma unroll
        for (int n = 0; n < 2; ++n) { const int c = c0 + 16 * n + 4 * fq; bf16* xp = X + (size_t)row * D + c;
            const v2u xi = *(const v2u*)xp; const f32x4 gv = *(const f32x4*)(g1 + c) * pg8::WSC_INV; const f32x4 ac = n == 0 ? acc0 : acc1;
            const f32x4 v = (f32x4){bflo(xi.x), bfhi(xi.x), bflo(xi.y), bfhi(xi.y)} + ac * gv;
            v2u w; w.x = cvt_pk_bf16(v[0], v[1]); w.y = cvt_pk_bf16(v[2], v[3]); *(v2u*)xp = w; }
    }
}

__global__ void __launch_bounds__(NTHR, 2) fwd_kernel(Args args) {
    extern __shared__ __attribute__((aligned(16))) unsigned char lds_raw[];
    LAS unsigned char* lds = (LAS unsigned char*)lds_raw;
    const int tid = threadIdx.x;
    for (int u = tid; u < (LDS_BYTES - LDSCTL_OFF) / 4; u += NTHR) ((LAS unsigned*)(lds + LDSCTL_OFF))[u] = 0u;
    __syncthreads();
    unsigned* ctl = (unsigned*)(args.ws + WS_CTL);
    XcdBarrier bar; bar.bar = ctl + CW_BAR; bar.x = 0; bar.st = nullptr;
#if MK_ONE_LAUNCH
    bar = xcd_barrier_post(ctl + CW_BAR, (volatile LAS unsigned*)(lds + LDSCTL_OFF));
#endif
    const int lo = args.ph_lo, hi = args.ph_hi;
#define IN(k) (lo <= (k) && (k) < hi)
#if MK_ONE_LAUNCH
#define SEAM(k) do { if (IN(k) && IN((k) + 1)) xcd_barrier(bar); } while (0)
#else
#define SEAM(k) do { } while (0)
#endif
    LAS int* lctl = (LAS int*)(lds + LDSCTL_OFF + 256);
    const int G = gridDim.x;
    if (IN(0)) { phase_prologue(lds); } SEAM(0);
    for (int l = 0; l < DEPTH; ++l) {
        const int p0 = 1 + 10 * l;
        if (IN(p0 + 0)) { phase_norm1<0>(l, lds); } SEAM(p0 + 0);
        if (IN(p0 + 1)) {
            KArgs& A = get_args(); unsigned char* ws = A.ws;
            pg8::DenseSched S; S.init(ws + WS_ACT, ws + WS_WIN + (size_t)l * NPX * D, MT, NPX, G, (int)blockIdx.x, (size_t)256 * 1024);
            { pg8::DenseSched S0 = S; S0.nN = 9; S0.nwg = S0.nM * 9; S0.part(0xEDBA54310ull, 0);
              pg8::EpiInProj<false> E0{(bf16*)(ws + WS_PX), MT, (bf16*)(ws + WS_VTB), ws + WS_DLT, (const float*)(ws + WS_ROPE), ws + WS_QK2};
              pg8::gemm_phase<pg8::EpiInProj<false>, pg8::DenseSched>(lds, S0, E0); }
            __syncthreads();
            { pg8::DenseSched S1 = S; S1.nN = 2; S1.nwg = S1.nM * 2; S1.part(0x76ull, S.nM * 9);
              pg8::EpiInProjK E1{(bf16*)(ws + WS_KN), A.in[I_KNORM] + l * 64};
              pg8::gemm_phase<pg8::EpiInProjK, pg8::DenseSched>(lds, S1, E1); }
            __syncthreads();
            { pg8::DenseSched S2 = S; S2.nN = 4; S2.nwg = S2.nM * 4; S2.part(0xC982ull, S.nM * 11);
              pg8::EpiInProj<true> E2{(bf16*)(ws + WS_PX), MT, (bf16*)(ws + WS_VTB), ws + WS_DLT, (const float*)(ws + WS_ROPE), ws + WS_QK2};
              pg8::gemm_phase<pg8::EpiInProj<true>, pg8::DenseSched>(lds, S2, E2); }
        } SEAM(p0 + 1);
        if (IN(p0 + 2)) { phase_prepass(l); } SEAM(p0 + 2);
        if (IN(p0 + 3)) { phase_stats(l, lds); } SEAM(p0 + 3);
        if (IN(p0 + 4)) { phase_scan(l, lds); } SEAM(p0 + 4);
        if (IN(p0 + 5)) { phase_mixout(l, lds); } SEAM(p0 + 5);
        if (IN(p0 + 6)) {
            KArgs& A = get_args(); unsigned char* ws = A.ws;
            pg8::DenseSched S; S.init(ws + WS_MIX, ws + WS_WOUT + (size_t)l * D * D, ML, D, G, (int)blockIdx.x, (size_t)256 * 1024);
            pg8::EpiResGate E{(bf16*)(ws + WS_X), (const float*)(ws + WS_MOD) + (size_t)l * 5 * 6144 + 2 * 1024};
            pg8::gemm_phase<pg8::EpiResGate, pg8::DenseSched>(lds, S, E);
            if (l < DEPTH - 1) outproj_ctx(l);
        } SEAM(p0 + 6);
        if (IN(p0 + 7)) { phase_norm2(l, lds); } SEAM(p0 + 7);
        if (IN(p0 + 8)) {
            KArgs& A = get_args(); unsigned char* ws = A.ws;
            moe_offsets(l, lctl);
            pg8::MoeSched<true> S{lctl, lctl + 64, (const char*)(ws + WS_ACT), (const char*)(ws + WS_WUP) + (size_t)l * NE * 2048 * D, (const int*)(ws + WS_ROWTOK), (size_t)2048 * D, lctl[32], 8, G, vcu_of((int)blockIdx.x, G)};
            pg8::EpiSwiglu E{(unsigned char*)(ws + WS_H), A.in[I_BUP] + (size_t)l * NE * 2048};
            pg8::gemm_phase<pg8::EpiSwiglu, pg8::MoeSched<true>>(lds, S, E);
        } SEAM(p0 + 8);
        if (IN(p0 + 9)) {
            KArgs& A = get_args(); unsigned char* ws = A.ws;
            moe_offsets(l, lctl);
            pg8::MoeSched<false> S{lctl, lctl + 64, (const char*)(ws + WS_H), (const char*)(ws + WS_WDN) + (size_t)l * NE * D * D, nullptr, (size_t)D * D, lctl[32], 4, G, vcu_of((int)blockIdx.x, G)};
            pg8::EpiDown E{(unsigned char*)(ws + WS_Y), A.in[I_BDN] + (size_t)l * NE * D, (const float*)(ws + WS_ROWGATE)};
            pg8::gemm_phase<pg8::EpiDown, pg8::MoeSched<false>>(lds, S, E);
        } SEAM(p0 + 9);
    }
    if (IN(N_PHASES - 1)) { phase_norm1<1>(0, lds); }
#undef IN
#undef SEAM
}

extern "C" void kernel_launch(void* const* d_in, const int* in_sizes, int n_in, void* d_out, int out_size, void* d_ws, size_t ws_size, hipStream_t stream) {
    static int grid = 0;
    if (grid == 0) {
        if (n_in != 24 || in_sizes[0] != ML * D || out_size != ML * D || ws_size < WS_END) { fprintf(stderr, "kernel_launch: unexpected shapes (n_in %d, in0 %d, out %d, ws %zu)\n", n_in, n_in > 0 ? in_sizes[0] : -1, out_size, ws_size); grid = -1; return; }
        int dev = 0, cus = 0, per_cu = 0;
        if (hipGetDevice(&dev) != hipSuccess || hipDeviceGetAttribute(&cus, hipDeviceAttributeMultiprocessorCount, dev) != hipSuccess) { grid = -1; return; }
        if (hipFuncSetAttribute((const void*)fwd_kernel, hipFuncAttributeMaxDynamicSharedMemorySize, LDS_BYTES) != hipSuccess) { fprintf(stderr, "kernel_launch: hipFuncSetAttribute failed\n"); grid = -1; return; }
        if (hipOccupancyMaxActiveBlocksPerMultiprocessor(&per_cu, (const void*)fwd_kernel, NTHR, LDS_BYTES) != hipSuccess || per_cu < 1) { fprintf(stderr, "kernel_launch: occupancy query says %d\n", per_cu); }
        (void)hipGetLastError();
        grid = cus;
    }
    if (grid < 0) return;
    (void)hipMemsetAsync((char*)d_ws + WS_CTL, 0, CTL_ZERO_BYTES, stream);
    Args a{};
    for (int i = 0; i < 24; ++i) a.in[i] = (const float*)d_in[i];
    a.out = (float*)d_out; a.ws = (unsigned char*)d_ws;
#if MK_ONE_LAUNCH
    a.ph_lo = 0; a.ph_hi = N_PHASES;
    hipLaunchKernelGGL(fwd_kernel, dim3(grid), dim3(NTHR), LDS_BYTES, stream, a);
#else
    for (int p = 0; p < N_PHASES; ++p) { a.ph_lo = p; a.ph_hi = p + 1; hipLaunchKernelGGL(fwd_kernel, dim3(grid), dim3(NTHR), LDS_BYTES, stream, a); }
#endif
}
```

```cpp
#include <hip/hip_runtime.h>
#include <cstdio>
#include <cstdint>

#ifndef MK_ONE_LAUNCH
#define MK_ONE_LAUNCH 1
#endif

constexpr int D = 1024, NB = 4, SEQ = 8192, DEPTH = 4, CTXL = 256;
constexpr int ML = NB * SEQ;
constexpr int MC = NB * CTXL;
constexpr int MT = ML + MC;
constexpr int DIN = 3600, NPX = 3840;
constexpr int NE = 32;
constexpr int NCH = 132;
constexpr int NSEQ = 32;
constexpr int CAP = MT;
constexpr int MOE_TILES_MAX = 560;
constexpr float EPS = 1e-6f;
constexpr int C_MQ = 0, C_MK = 256, C_MV = 512, C_MO = 768, C_NQ = 1024, C_NK = 1536, C_NV = 2048, C_RQ = 2560, C_RK = 2816, C_RV = 3072, C_RG = 3328, C_GATE = 3584;

constexpr size_t MiB = 1u << 20;
constexpr size_t WS_CTL = 0, CTL_ZERO_BYTES = 1 * MiB;
constexpr size_t WS_MOD = 1 * MiB;
constexpr size_t WS_ROPE = 2 * MiB;
constexpr size_t WS_MISC = 3 * MiB;
constexpr size_t WS_X = 4 * MiB;
constexpr size_t WS_ACT = 136 * MiB;
constexpr size_t WS_PX = 202 * MiB;
constexpr size_t WS_MIX = 450 * MiB;
constexpr size_t WS_CLOC = 516 * MiB;
constexpr size_t WS_RLOC = 582 * MiB;
constexpr size_t WS_CPREV = 648 * MiB;
constexpr size_t WS_RPREV = 681 * MiB;
constexpr size_t WS_NLOC = 714 * MiB;
constexpr size_t WS_NPREV = 716 * MiB;
constexpr size_t WS_ROWTOK = 719 * MiB;
constexpr size_t WS_ROWGATE = 724 * MiB;
constexpr size_t WS_TOKSLOT = 729 * MiB;
constexpr size_t WS_H = 730 * MiB;
constexpr size_t WS_Y = 1010 * MiB;
constexpr size_t WS_WIN = 1290 * MiB;
constexpr size_t WS_WOUT = 1320 * MiB;
constexpr size_t WS_WUP = 1328 * MiB;
constexpr size_t WS_WDN = 1840 * MiB;
constexpr size_t WS_KN = 2096 * MiB;
constexpr size_t WS_VTB = 2198 * MiB;
constexpr size_t WS_QK2 = 2130 * MiB;
constexpr size_t WS_DLT = 2300 * MiB;
constexpr size_t WS_END = 2366 * MiB;
constexpr int VTB_H = 24;
constexpr int CW_TMO = 0, CW_BAR = 4096, CW_CNT = 8192;

constexpr int LDS_BYTES = 147456;
constexpr int LDSCTL_OFF = 143360;
constexpr int NWAVES = 8, NTHR = 512;

#define GAS __attribute__((address_space(1)))
#define LAS __attribute__((address_space(3)))
typedef unsigned short bf16;
typedef unsigned v4u __attribute__((ext_vector_type(4)));
typedef unsigned v2u __attribute__((ext_vector_type(2)));
typedef float f32x4 __attribute__((ext_vector_type(4)));
typedef short bf16x8 __attribute__((ext_vector_type(8)));
#define RLX_AGENT __ATOMIC_RELAXED, __HIP_MEMORY_SCOPE_AGENT
#define LDS_WAIT() asm volatile("s_waitcnt lgkmcnt(0)" ::: "memory")

__device__ __forceinline__ unsigned cvt_pk_bf16(float lo, float hi) { unsigned r; asm volatile("v_cvt_pk_bf16_f32 %0, %1, %2" : "=v"(r) : "v"(lo), "v"(hi)); return r; }
__device__ __forceinline__ bf16 f2bf(float f) { return (bf16)(cvt_pk_bf16(f, 0.f) & 0xffffu); }
__device__ __forceinline__ float bf2f(unsigned b) { return __uint_as_float(b << 16); }
__device__ __forceinline__ float bflo(unsigned u) { return __uint_as_float(u << 16); }
__device__ __forceinline__ float bfhi(unsigned u) { return __uint_as_float(u & 0xffff0000u); }
__device__ __forceinline__ void unpack8(v4u r, float (&o)[8]) { o[0] = bflo(r.x); o[1] = bfhi(r.x); o[2] = bflo(r.y); o[3] = bfhi(r.y); o[4] = bflo(r.z); o[5] = bfhi(r.z); o[6] = bflo(r.w); o[7] = bfhi(r.w); }
__device__ __forceinline__ v4u pack8(const float (&o)[8]) { v4u r; r.x = cvt_pk_bf16(o[0], o[1]); r.y = cvt_pk_bf16(o[2], o[3]); r.z = cvt_pk_bf16(o[4], o[5]); r.w = cvt_pk_bf16(o[6], o[7]); return r; }
__device__ __forceinline__ int opq_tid() { int t = threadIdx.x; asm volatile("" : "+v"(t)); return t; }
__device__ __forceinline__ float shx(float v, int m, int lane) { return __int_as_float(__builtin_amdgcn_ds_bpermute((lane ^ m) << 2, __float_as_int(v))); }
__device__ __forceinline__ int shxi(int v, int m, int lane) { return __builtin_amdgcn_ds_bpermute((lane ^ m) << 2, v); }
__device__ __forceinline__ float shsrc(float v, int src) { return __int_as_float(__builtin_amdgcn_ds_bpermute(src << 2, __float_as_int(v))); }
__device__ __forceinline__ int shsrci(int v, int src) { return __builtin_amdgcn_ds_bpermute(src << 2, v); }
__device__ __forceinline__ float wave_sum(float v, int lane) {
#pragma unroll
    for (int o = 1; o < 64; o <<= 1) v += shx(v, o, lane);
    return v;
}
__device__ __forceinline__ float wave_max(float v, int lane) {
#pragma unroll
    for (int o = 1; o < 64; o <<= 1) v = fmaxf(v, shx(v, o, lane));
    return v;
}
__device__ __forceinline__ float sigmoidf_(float z) { return __builtin_amdgcn_rcpf(1.0f + __expf(-z)); }
__device__ __forceinline__ float siluf_(float z) { return z * __builtin_amdgcn_rcpf(1.0f + __expf(-z)); }
__device__ __forceinline__ float logsigmoidf_(float z) { return fminf(z, 0.f) - __logf(1.0f + __expf(-fabsf(z))); }
__device__ __forceinline__ f32x4 mfma16(bf16x8 a, bf16x8 b, f32x4 c) { return __builtin_amdgcn_mfma_f32_16x16x32_bf16(a, b, c, 0, 0, 0); }
__device__ __forceinline__ bf16x8 as_frag(v4u v) { return __builtin_bit_cast(bf16x8, v); }

#define XB_TMO      128
#define XB_XCNT(j)  (256  + 64 * (j))
#define XB_XSUB(j)  (1280 + 64 * (j))
#define XB_XGEN(j)  (2304 + 64 * (j))
#define XB_TOP      3328
#define XB_TOPGEN   3392
#define XCD_BAR_WORDS 3456
#define XB_SPIN_CAP (1u << 18)
__device__ __forceinline__ unsigned xb_ld(unsigned* p)              { return __hip_atomic_load(p, __ATOMIC_RELAXED, __HIP_MEMORY_SCOPE_AGENT); }
__device__ __forceinline__ unsigned xb_add(unsigned* p, unsigned v) { return __hip_atomic_fetch_add(p, v, __ATOMIC_RELAXED, __HIP_MEMORY_SCOPE_AGENT); }
__device__ __forceinline__ unsigned xb_xcc_id() { return (unsigned)__builtin_amdgcn_s_getreg((3 << 11) | 20) & 0xFu; }
#define XB_SPIN(cond, bar) do { unsigned _sp = 0; while (cond) { __builtin_amdgcn_s_sleep(1); \
    if ((++_sp & 255u) == 0u) { if (xb_ld(&(bar)[XB_TMO])) break; if (_sp > XB_SPIN_CAP) { atomicAdd(&(bar)[XB_TMO], 1u); break; } } } } while (0)
struct XcdBarrier { unsigned* bar; unsigned x; volatile LAS unsigned* st; };
__device__ __forceinline__ XcdBarrier xcd_barrier_post(unsigned* bar, volatile LAS unsigned* st) {
    XcdBarrier b; b.bar = bar; b.x = xb_xcc_id(); b.st = st;
    if (threadIdx.x == 0) (void)xb_add(&bar[XB_XCNT(b.x)], 1u);
    return b;
}
__device__ __forceinline__ void xcd_barrier_complete(unsigned* bar, unsigned x, unsigned& nloc, unsigned& nx) {
    const unsigned G = gridDim.x * gridDim.y * gridDim.z;
    unsigned sum, cnt, mine, sp = 0u;
    for (;;) {
        sum = 0u; cnt = 0u; mine = 0u;
#pragma unroll
        for (unsigned j = 0; j < 16; ++j) { const unsigned c = xb_ld(&bar[XB_XCNT(j)]); sum += c; cnt += (c > 0u) ? 1u : 0u; mine = (j == x) ? c : mine; }
        if (sum == G) break;
        __builtin_amdgcn_s_sleep(1);
        if ((++sp & 255u) == 0u) { if (xb_ld(&bar[XB_TMO])) break; if (sp > XB_SPIN_CAP) { atomicAdd(&bar[XB_TMO], 1u); break; } }
    }
    nloc = mine > 0u ? mine : 1u; nx = cnt > 0u ? cnt : 1u;
}
__device__ __forceinline__ void xcd_barrier(const XcdBarrier& b) {
    asm volatile("s_waitcnt vmcnt(0)" ::: "memory");
    __syncthreads();
    if (threadIdx.x == 0) {
        unsigned* bar = b.bar;
        __builtin_amdgcn_s_waitcnt(0);
        unsigned nloc = b.st[0], nx = b.st[1];
        if (nloc == 0u) { xcd_barrier_complete(bar, b.x, nloc, nx); b.st[0] = nloc; b.st[1] = nx; }
        const unsigned old = xb_add(&bar[XB_XSUB(b.x)], 1u);
        const unsigned gen = old / nloc;
        if (old + 1u == (gen + 1u) * nloc) {
            __builtin_amdgcn_fence(__ATOMIC_RELEASE, "agent");
            asm volatile("s_waitcnt vmcnt(0)" ::: "memory");
            const unsigned og = xb_add(&bar[XB_TOP], 1u);
            const unsigned tg = og / nx;
            if (og + 1u == (tg + 1u) * nx) xb_add(&bar[XB_TOPGEN], 1u);
            else XB_SPIN(xb_ld(&bar[XB_TOPGEN]) == tg, bar);
            __builtin_amdgcn_fence(__ATOMIC_ACQUIRE, "agent");
            xb_add(&bar[XB_XGEN(b.x)], 1u);
            asm volatile("s_waitcnt vmcnt(0)" ::: "memory");
        } else {
            XB_SPIN(xb_ld(&bar[XB_XGEN(b.x)]) == gen, bar);
            __builtin_amdgcn_fence(__ATOMIC_ACQUIRE, "agent");
            asm volatile("s_waitcnt vmcnt(0)" ::: "memory");
        }
    }
    __syncthreads();
}

namespace pg8 {
#define PG8_LAS __attribute__((address_space(3)))
constexpr int BM = 256, BK = 64, HALF = 128, HTB = HALF * BK * 2, STAGE_BYTES = 8 * HTB, NXCD = 8, WGM = 8;
constexpr int GK = 1024;
constexpr unsigned HSTEP = (unsigned)HALF * GK * 2;
constexpr size_t TSTEP = (size_t)2 * HSTEP;
__host__ __device__ __forceinline__ int lds_byte(int r, int c) { const int st = (r >> 4) * 2 + (c >> 5), rr = r & 15, cc = c & 31, ob = rr * 64 + cc * 2; return st * 1024 + (ob ^ (((ob >> 9) & 1) << 5)); }
__host__ __device__ __forceinline__ void stage_rc(int b, int& R, int& C) { const int st = b / 1024, sb = b % 1024, swz = sb ^ (((sb >> 9) & 1) << 5); R = (st >> 1) * 16 + swz / 64; C = (st & 1) * 32 + (swz % 64) / 2; }
__host__ __device__ __forceinline__ int perm32(int rho) { const int n = rho >> 4, i = rho & 15; return 8 * (i >> 2) + 4 * n + (i & 3); }

typedef int v8i_t __attribute__((ext_vector_type(8)));
typedef int v4i_t __attribute__((ext_vector_type(4)));
__device__ __forceinline__ v8i_t cat8(bf16x8 lo, bf16x8 hi) { const v4i_t a = __builtin_bit_cast(v4i_t, lo), b = __builtin_bit_cast(v4i_t, hi); return __builtin_shufflevector(a, b, 0, 1, 2, 3, 4, 5, 6, 7); }
constexpr int YROWS = 143360;
struct Unit { int pm, pn, e, jt, cnt; };

struct DenseSched {
    const char* A; const char* B; int nM, nN, nwg, G, c; size_t tstep;
    unsigned long long cmap; int i0, lbase;
    __device__ __forceinline__ void init(const void* A_, const void* B_, int M, int N, int G_, int c_, size_t tstep_ = TSTEP) { tstep = tstep_; A = (const char*)A_; B = (const char*)B_; nM = M / BM; nN = N / BM; nwg = nM * nN; G = G_; c = c_;
        cmap = 0xFEDCBA9876543210ull; i0 = 0; lbase = 0; }
    __device__ __forceinline__ void part(unsigned long long cmap_, int lbase_) { cmap = cmap_; lbase = lbase_; i0 = c < lbase_ ? (lbase_ - c + G - 1) / G : 0; }
    __device__ __forceinline__ bool next(int i, Unit& u) const {
        const long L = (long)(i + i0) * G + c - lbase; if (L >= nwg) return false;
        int wgid = (int)L; { const int q = nwg / NXCD, r = nwg % NXCD, xcd = wgid % NXCD, off = wgid / NXCD; wgid = (xcd < r ? xcd * (q + 1) : r * (q + 1) + (xcd - r) * q) + off; }
        const int nig = WGM * nN, gid = wgid / nig, fm = gid * WGM, gsz = (nM - fm) < WGM ? (nM - fm) : WGM;
        u.pm = fm + ((wgid % nig) % gsz); u.pn = (int)((cmap >> (4 * ((wgid % nig) / gsz))) & 15ull); u.e = 0; u.jt = 0; u.cnt = 0; return true;
    }
    static constexpr bool GATHERS = false;
    __device__ __forceinline__ const char* a_base(const Unit& u) const { return A + (size_t)u.pm * tstep; }
    __device__ __forceinline__ const char* b_base(const Unit& u) const { return B + (size_t)u.pn * tstep; }
    __device__ __forceinline__ void a_offs(const Unit&, unsigned (&)[2][2], const int (&)[2], const int (&)[2]) const {}
};
template <bool GATHER> struct MoeSched {
    static constexpr unsigned RBm = 1024u;
    const PG8_LAS int* tstart; const PG8_LAS int* ecnt; const char* A; const char* B; const int* rowtok; size_t bstride; int ntiles, nN, G, c;
    __device__ __forceinline__ bool next(int i, Unit& u) const {
        const int L = i * G + c; if (L >= ntiles * nN) return false;
        u.pm = L / nN; u.pn = L % nN;
        const int e = tstart[128 + u.pm];
        u.e = e; u.jt = u.pm - tstart[e]; u.cnt = ecnt[e]; return true;
    }
    static constexpr bool GATHERS = GATHER;
    __device__ __forceinline__ const char* a_base(const Unit& u) const { return GATHER ? A : A + (size_t)u.pm * (256u * RBm); }
    __device__ __forceinline__ const char* b_base(const Unit& u) const { return B + (size_t)u.e * bstride + (size_t)u.pn * (256u * RBm); }
    __device__ __forceinline__ void a_offs(const Unit& u, unsigned (&vo)[2][2], const int (&R)[2], const int (&C)[2]) const {
#pragma unroll
        for (int h = 0; h < 2; ++h)
#pragma unroll
            for (int i = 0; i < 2; ++i) {
                if (GATHER) { const int rr = u.jt * 256 + h * 128 + R[i]; const int tok = (rr < u.cnt) ? rowtok[(size_t)u.e * CAP + rr] : 0; vo[h][i] = (unsigned)tok * RBm + (unsigned)C[i] * 2u; }
            }
    }
};

constexpr float WSC = 16.0f, WSC_INV = 1.0f / 16.0f;
constexpr float YSC = 16.0f, YSC_INV = 1.0f / 16.0f;
__device__ __forceinline__ unsigned pk4_fp8(float a, float b, float c, float d) { int w = 0; w = __builtin_amdgcn_cvt_pk_fp8_f32(a, b, w, false); w = __builtin_amdgcn_cvt_pk_fp8_f32(c, d, w, true); return (unsigned)w; }
template <bool F8_> struct EpiBf16T {
    static constexpr bool PERM = true, F8 = F8_, SWP = false, HGRP = false;
    bf16* O; int ldc;
    __device__ __forceinline__ void operator()(const f32x4 (&acc)[2][2][4][2], const Unit& u, int wr, int wc, int fr, int fq) const {
        const int row0 = u.pm * BM + wr * 64 + fr, col0 = u.pn * BM + wc * 32 + 8 * fq;
#pragma unroll
        for (int ai = 0; ai < 2; ++ai)
#pragma unroll
            for (int m = 0; m < 4; ++m) { const int row = row0 + ai * HALF + m * 16;
#pragma unroll
                for (int bj = 0; bj < 2; ++bj) { const f32x4 v0 = F8_ ? acc[ai][bj][m][0] * WSC_INV : acc[ai][bj][m][0], v1 = F8_ ? acc[ai][bj][m][1] * WSC_INV : acc[ai][bj][m][1]; const int c = col0 + bj * HALF;
                    v4u w; w.x = cvt_pk_bf16(v0[0], v0[1]); w.y = cvt_pk_bf16(v0[2], v0[3]); w.z = cvt_pk_bf16(v1[0], v1[1]); w.w = cvt_pk_bf16(v1[2], v1[3]);
                    *(v4u*)(O + ((size_t)(c >> 6) * ldc + row) * 64 + (c & 63)) = w; } }
    }
};
template <bool SWP_> struct EpiInProj {
    static constexpr bool PERM = true, F8 = true, SWP = SWP_, HGRP = false;
    static constexpr int NST = 16;
    bf16* O; int ldc; bf16* VT; unsigned char* G8; const float* rope; unsigned char* qk8;
    __device__ __forceinline__ void operator()(const f32x4 (&acc)[2][2][4][2], const Unit& u, int wr, int wc, int fr, int fq) const {
        if constexpr (SWP_) {
            const int hb = u.pn == 2 ? 8 : (u.pn == 8 ? 0 : (u.pn == 9 ? 4 : 12));
#pragma unroll
            for (int ai = 0; ai < 2; ++ai)
#pragma unroll
                for (int mp = 0; mp < 2; ++mp) { const int ublk = u.pm * 8 + ai * 4 + wr * 2 + mp;
#pragma unroll
                    for (int bj = 0; bj < 2; ++bj)
#pragma unroll
                        for (int n = 0; n < 2; ++n) { const int cl = bj * HALF + wc * 32 + 8 * (fr >> 2) + 4 * n + (fr & 3);
                            const f32x4 v0 = acc[ai][bj][2 * mp][n] * WSC_INV, v1 = acc[ai][bj][2 * mp + 1][n] * WSC_INV;
                            v4u w; w.x = cvt_pk_bf16(v0[0], v0[1]); w.y = cvt_pk_bf16(v0[2], v0[3]); w.z = cvt_pk_bf16(v1[0], v1[1]); w.w = cvt_pk_bf16(v1[2], v1[3]);
                            *(v4u*)(VT + ((((size_t)ublk * VTB_H + hb + (cl >> 6)) * 4 + fq) * 64 + (cl & 63)) * 8) = w; } }
            return;
        }
        const int row0 = u.pm * BM + wr * 64 + fr, col0 = u.pn * BM + wc * 32 + 8 * fq;
        const bool gate_tile = u.pn == 14;
        if (gate_tile && (wc != 0 || fq >= 2)) return;
        if (u.pn == 10 || u.pn == 11) {
            const bool isk = u.pn == 11, mainrow = u.pm < ML / BM; const float sc = (isk ? 0.125f : 1.0f) * 4.0f * WSC_INV;
            const int half = wc & 1, lane = fr + 16 * fq; const float sg = fq >= 2 ? 1.0f : -1.0f;
#pragma unroll
            for (int ai = 0; ai < 2; ++ai)
#pragma unroll
                for (int m = 0; m < 4; ++m) { const int row = row0 + ai * HALF + m * 16, t = row & (SEQ - 1), pos = half ? 128 + (t & 63) : (t >> 6);
                    const float* cs = rope + ((size_t)pos * 16 + 8 * (fq & 1)) * 2;
                    f32x4 c4[4];
#pragma unroll
                    for (int q4 = 0; q4 < 4; ++q4) c4[q4] = mainrow ? *(const f32x4*)(cs + 4 * q4) : (f32x4){1.f, 0.f, 1.f, 0.f};
#pragma unroll
                    for (int bj = 0; bj < 2; ++bj) { float o[8];
#pragma unroll
                        for (int j = 0; j < 8; ++j) { const float x = acc[ai][bj][m][j >> 2][j & 3]; const float xp = shx(x, 32, lane);
                            o[j] = (x * c4[j >> 1][(j & 1) * 2] + sg * xp * c4[j >> 1][(j & 1) * 2 + 1]) * sc; }
                        v2u w; w.x = pk4_fp8(o[0], o[1], o[2], o[3]); w.y = pk4_fp8(o[4], o[5], o[6], o[7]);
                        *(v2u*)(qk8 + ((size_t)(8 + (isk ? 4 : 0) + 2 * bj + (wc >> 1)) * ldc + row) * 64 + half * 32 + 8 * fq) = w; } }
            return;
        }
        if (u.pn == 3 || u.pn == 13) {
            const int cc0 = (u.pn == 3 ? 0 : BM) + wc * 32 + 8 * fq;
#pragma unroll
            for (int ai = 0; ai < 2; ++ai)
#pragma unroll
                for (int m = 0; m < 4; ++m) { const int row = row0 + ai * HALF + m * 16;
#pragma unroll
                    for (int bj = 0; bj < 2; ++bj) { const f32x4 v0 = acc[ai][bj][m][0] * 0.25f, v1 = acc[ai][bj][m][1] * 0.25f; const int c = cc0 + bj * HALF;
                        v2u w; w.x = pk4_fp8(v0[0], v0[1], v0[2], v0[3]); w.y = pk4_fp8(v1[0], v1[1], v1[2], v1[3]);
                        *(v2u*)(G8 + ((size_t)(c >> 6) * ldc + row) * 64 + (c & 63)) = w; } }
            return;
        }
#pragma unroll
        for (int ai = 0; ai < 2; ++ai)
#pragma unroll
            for (int m = 0; m < 4; ++m) { const int row = row0 + ai * HALF + m * 16;
#pragma unroll
                for (int bj = 0; bj < 2; ++bj) { if (bj == 1 && gate_tile) continue;
                    const f32x4 v0 = acc[ai][bj][m][0] * WSC_INV, v1 = acc[ai][bj][m][1] * WSC_INV; const int c = col0 + bj * HALF;
                    v4u w; w.x = cvt_pk_bf16(v0[0], v0[1]); w.y = cvt_pk_bf16(v0[2], v0[3]); w.z = cvt_pk_bf16(v1[0], v1[1]); w.w = cvt_pk_bf16(v1[2], v1[3]);
                    *(v4u*)(O + ((size_t)(c >> 6) * ldc + row) * 64 + (c & 63)) = w; } }
    }
};
struct EpiInProjK {
    static constexpr bool PERM = true, F8 = true, SWP = false, HGRP = true;
    static constexpr int NST = 16;
    bf16* KN; const float* kw;
    __device__ __forceinline__ void operator()(const f32x4 (&acc)[2][2][4][2], const Unit& u, int wr, int wc, int fr, int fq) const {
        const int row0 = u.pm * BM + wr * 64 + fr, head = (u.pn - 6) * 4 + wc, lane = fr + 16 * fq;
        f32x4 kv[2][2];
#pragma unroll
        for (int bj = 0; bj < 2; ++bj)
#pragma unroll
            for (int n = 0; n < 2; ++n) kv[bj][n] = *(const f32x4*)(kw + bj * 32 + 8 * fq + 4 * n);
#pragma unroll
        for (int ai = 0; ai < 2; ++ai)
#pragma unroll
            for (int m = 0; m < 4; ++m) { const int row = row0 + ai * HALF + m * 16;
                f32x4 x[2][2]; float ss = 0.f;
#pragma unroll
                for (int bj = 0; bj < 2; ++bj)
#pragma unroll
                    for (int n = 0; n < 2; ++n) { x[bj][n] = acc[ai][bj][m][n] * WSC_INV; ss += (x[bj][n][0] * x[bj][n][0] + x[bj][n][1] * x[bj][n][1]) + (x[bj][n][2] * x[bj][n][2] + x[bj][n][3] * x[bj][n][3]); }
                ss += shx(ss, 16, lane); ss += shx(ss, 32, lane);
                const float rn = rsqrtf(ss * (1.0f / 64.0f) + EPS);
#pragma unroll
                for (int bj = 0; bj < 2; ++bj) { const f32x4 v0 = x[bj][0] * rn * kv[bj][0], v1 = x[bj][1] * rn * kv[bj][1];
                    v4u w; w.x = cvt_pk_bf16(v0[0], v0[1]); w.y = cvt_pk_bf16(v0[2], v0[3]); w.z = cvt_pk_bf16(v1[0], v1[1]); w.w = cvt_pk_bf16(v1[2], v1[3]);
                    *(v4u*)(KN + ((size_t)head * MT + row) * 64 + bj * 32 + 8 * fq) = w; } }
    }
};
struct EpiResGate {
    static constexpr bool PERM = true, F8 = true, SWP = false, HGRP = false; static constexpr int NST = 16;
    bf16* O; const float* mod;
    __device__ __forceinline__ void operator()(const f32x4 (&acc)[2][2][4][2], const Unit& u, int wr, int wc, int fr, int fq) const {
        const int row0 = u.pm * BM + wr * 64 + fr, col0 = u.pn * BM + wc * 32 + 8 * fq;
        const int mb = u.pm < 128 ? (u.pm >> 5) : 4;
        const float* g = mod + (size_t)mb * 6144 + col0;
        v4u xin[2][4][2];
#pragma unroll
        for (int ai = 0; ai < 2; ++ai)
#pragma unroll
            for (int m = 0; m < 4; ++m)
#pragma unroll
                for (int bj = 0; bj < 2; ++bj) xin[ai][m][bj] = *(const v4u*)(O + (size_t)(row0 + ai * HALF + m * 16) * D + col0 + bj * HALF);
        f32x4 gv[2][2];
#pragma unroll
        for (int bj = 0; bj < 2; ++bj)
#pragma unroll
            for (int n = 0; n < 2; ++n) gv[bj][n] = *(const f32x4*)(g + bj * HALF + 4 * n) * WSC_INV;
#pragma unroll
        for (int ai = 0; ai < 2; ++ai)
#pragma unroll
            for (int m = 0; m < 4; ++m) { bf16* rowp = O + (size_t)(row0 + ai * HALF + m * 16) * D + col0;
#pragma unroll
                for (int bj = 0; bj < 2; ++bj) { const v4u xi = xin[ai][m][bj];
                    const f32x4 x0 = (f32x4){bflo(xi.x), bfhi(xi.x), bflo(xi.y), bfhi(xi.y)}, x1 = (f32x4){bflo(xi.z), bfhi(xi.z), bflo(xi.w), bfhi(xi.w)};
                    const f32x4 v0 = x0 + acc[ai][bj][m][0] * gv[bj][0], v1 = x1 + acc[ai][bj][m][1] * gv[bj][1];
                    v4u w; w.x = cvt_pk_bf16(v0[0], v0[1]); w.y = cvt_pk_bf16(v0[2], v0[3]); w.z = cvt_pk_bf16(v1[0], v1[1]); w.w = cvt_pk_bf16(v1[2], v1[3]);
                    *(v4u*)(rowp + bj * HALF) = w; } }
    }
};
struct EpiSwiglu {
    static constexpr bool PERM = true, F8 = true, SWP = false, HGRP = false;
    unsigned char* H; const float* bup;
    __device__ __forceinline__ void operator()(const f32x4 (&acc)[2][2][4][2], const Unit& u, int wr, int wc, int fr, int fq) const {
        const int row0 = u.pm * BM + wr * 64 + fr, j0 = u.pn * 128 + wc * 32 + 8 * fq;
        const float* bp = bup + (size_t)u.e * 2048 + 2 * j0;
        f32x4 bq[4];
#pragma unroll
        for (int q = 0; q < 4; ++q) bq[q] = *(const f32x4*)(bp + 4 * q);
#pragma unroll
        for (int ai = 0; ai < 2; ++ai)
#pragma unroll
            for (int m = 0; m < 4; ++m) { unsigned char* rowp = H + (size_t)(row0 + ai * HALF + m * 16) * 1024 + j0;
                float o[8];
#pragma unroll
                for (int n = 0; n < 2; ++n)
#pragma unroll
                    for (int i = 0; i < 4; ++i) { const int q = 2 * n + (i >> 1);
                        float glu = acc[ai][0][m][n][i] * WSC_INV + bq[q][(i & 1) * 2], lin = acc[ai][1][m][n][i] * WSC_INV + bq[q][(i & 1) * 2 + 1];
                        glu = fminf(glu, 7.0f); lin = fminf(fmaxf(lin, -7.0f), 7.0f);
                        const float ex = __builtin_amdgcn_exp2f(glu * (-1.702f * 1.4426950408889634f));
                        o[4 * n + i] = glu * __builtin_amdgcn_rcpf(1.0f + ex) * (lin + 1.0f); }
                v2u w; w.x = pk4_fp8(o[0], o[1], o[2], o[3]); w.y = pk4_fp8(o[4], o[5], o[6], o[7]);
                *(v2u*)rowp = w; }
    }
};
struct EpiDown {
    static constexpr bool PERM = true, F8 = true, SWP = false, HGRP = false; static constexpr int NST = 16;
    unsigned char* Y; const float* bd; const float* rowgate;
    __device__ __forceinline__ void operator()(const f32x4 (&acc)[2][2][4][2], const Unit& u, int wr, int wc, int fr, int fq) const {
        const int row0 = u.pm * BM + wr * 64 + fr, col0 = u.pn * BM + wc * 32 + 8 * fq;
        const float* bp = bd + (size_t)u.e * 1024 + col0;
        f32x4 bv[2][2];
#pragma unroll
        for (int bj = 0; bj < 2; ++bj)
#pragma unroll
            for (int n = 0; n < 2; ++n) bv[bj][n] = *(const f32x4*)(bp + bj * HALF + 4 * n) * YSC;
#pragma unroll
        for (int ai = 0; ai < 2; ++ai)
#pragma unroll
            for (int m = 0; m < 4; ++m) {
                const int row = row0 + ai * HALF + m * 16;
#pragma unroll
                for (int bj = 0; bj < 2; ++bj) { const f32x4 v0 = acc[ai][bj][m][0] * (WSC_INV * YSC) + bv[bj][0], v1 = acc[ai][bj][m][1] * (WSC_INV * YSC) + bv[bj][1]; const int c = col0 + bj * HALF;
                    v2u w; w.x = pk4_fp8(v0[0], v0[1], v0[2], v0[3]); w.y = pk4_fp8(v1[0], v1[1], v1[2], v1[3]);
                    *(v2u*)(Y + ((size_t)(c >> 6) * YROWS + row) * 64 + (c & 63)) = w; } }
    }
};

template <class Epi, class Sched>
__device__ __forceinline__ void gemm_phase(PG8_LAS unsigned char* lds, const Sched& S, const Epi& E) {
    const int tid = opq_tid(), wid = __builtin_amdgcn_readfirstlane(tid >> 6), lane = tid & 63, wr = wid >> 2, wc = wid & 3, fr = lane & 15, fq = lane >> 4;
    constexpr bool F8 = Epi::F8;
    constexpr unsigned RB = F8 ? 1024u : 2048u;
    constexpr int nt = F8 ? 8 : 16;
    constexpr bool GA = Sched::GATHERS;
    int RA[2], CA[2]; unsigned voffA[2], voffB[2];
#pragma unroll
    for (int i = 0; i < 2; ++i) { int R, C; stage_rc(tid * 16 + i * 8192, R, C); const int Rb = Epi::HGRP ? ((R >> 5) * 64 + perm32(R & 31)) : (Epi::PERM ? ((R & ~31) + perm32(R & 31)) : R);
        RA[i] = R; CA[i] = C; voffA[i] = (unsigned)R * RB + (unsigned)C * 2u; voffB[i] = (unsigned)Rb * RB + (unsigned)C * 2u; }
    constexpr size_t kstep = (size_t)(BK * 2);
    constexpr size_t hstep = (size_t)HALF * RB;
    constexpr size_t bhstep = Epi::HGRP ? (size_t)32 * RB : hstep;
    const unsigned ldsw = (unsigned)wid * 1024u;
    const int aoff = lds_byte(wr * 64 + fr, fq * 8), boff = lds_byte(wc * 32 + fr, fq * 8);
#define PG8_SA(b, h) (((b) * 2 + (h)) * HTB)
#define PG8_SB(b, h) ((4 + (b) * 2 + (h)) * HTB)
#define PG8_STAGE(bufoff, gbase, voff) do { _Pragma("unroll") for (int _i = 0; _i < 2; ++_i) \
        __builtin_amdgcn_global_load_lds((const unsigned*)((const char*)(gbase) + (voff)[_i]), (PG8_LAS unsigned*)(lds + (bufoff) + ldsw + _i * 8192), 16, 0, 0); } while (0)
#define PG8_LDA(dst, b, h) do { _Pragma("unroll") for (int m = 0; m < 4; ++m) _Pragma("unroll") for (int k = 0; k < 2; ++k) dst[m][k] = *(const PG8_LAS bf16x8*)(lds + PG8_SA(b, h) + aoff + m * 2048 + k * 1024); } while (0)
#define PG8_LDB(dst, b, h) do { _Pragma("unroll") for (int n = 0; n < 2; ++n) _Pragma("unroll") for (int k = 0; k < 2; ++k) dst[n][k] = *(const PG8_LAS bf16x8*)(lds + PG8_SB(b, h) + boff + n * 2048 + k * 1024); } while (0)
#define PG8_MMA(ai, bj, At, Bt) do { __builtin_amdgcn_s_setprio(1); _Pragma("unroll") for (int m = 0; m < 4; ++m) _Pragma("unroll") for (int n = 0; n < 2; ++n) { \
        if constexpr (F8) { const v8i_t _a = cat8(Bt[n][0], Bt[n][1]), _b = cat8(At[m][0], At[m][1]); \
            if constexpr (Epi::SWP) asm volatile("v_mfma_scale_f32_16x16x128_f8f6f4 %0, %2, %1, %0, %3, %3 op_sel_hi:[0,0,0]" : "+v"(acc[ai][bj][m][n]) : "v"(_a), "v"(_b), "v"(f8scale)); \
            else asm volatile("v_mfma_scale_f32_16x16x128_f8f6f4 %0, %1, %2, %0, %3, %3 op_sel_hi:[0,0,0]" : "+v"(acc[ai][bj][m][n]) : "v"(_a), "v"(_b), "v"(f8scale)); } \
        else { _Pragma("unroll") for (int k = 0; k < 2; ++k) acc[ai][bj][m][n] = __builtin_amdgcn_mfma_f32_16x16x32_bf16(Bt[n][k], At[m][k], acc[ai][bj][m][n], 0, 0, 0); } } __builtin_amdgcn_s_setprio(0); } while (0)
#define PG8_STA(bufoff, gbase, h, vo) do { if constexpr (GA) { PG8_STAGE(bufoff, gbase, vo[h]); } else { PG8_STAGE(bufoff, (gbase) + (h) * hstep, voffA); } } while (0)
#define PG8_WAIT_V(n) asm volatile("s_waitcnt vmcnt(" #n ")" ::: "memory")
#define PG8_WAIT_L(n) asm volatile("s_waitcnt lgkmcnt(" #n ")" ::: "memory")
#define PG8_BAR __builtin_amdgcn_s_barrier()
#define PG8_SCHED __builtin_amdgcn_sched_barrier(0)
    Unit cur, nxt; int ui = 0;
    if (!S.next(0, cur)) return;
    f32x4 acc[2][2][4][2];
#pragma unroll
    for (int a = 0; a < 2; ++a)
#pragma unroll
        for (int b = 0; b < 2; ++b)
#pragma unroll
            for (int m = 0; m < 4; ++m)
#pragma unroll
                for (int n = 0; n < 2; ++n) acc[a][b][m][n] = (f32x4){0.f, 0.f, 0.f, 0.f};
    bf16x8 At[4][2], B0[2][2], B1[2][2];
    const int f8scale = 0x7f7f7f7f;
    unsigned voA[2][2], nvoA[2][2];
    const char* cA = S.a_base(cur); const char* cB = S.b_base(cur);
    if constexpr (GA) S.a_offs(cur, voA, RA, CA);
    PG8_STAGE(PG8_SB(0, 0), cB, voffB); PG8_STAGE(PG8_SB(0, 1), cB + bhstep, voffB); PG8_STA(PG8_SA(0, 0), cA, 0, voA); PG8_STA(PG8_SA(0, 1), cA, 1, voA);
    if (wr == 1) PG8_BAR;
    PG8_WAIT_V(2); PG8_BAR;
    PG8_STAGE(PG8_SB(1, 0), cB + kstep, voffB); PG8_STA(PG8_SA(1, 0), cA + kstep, 0, voA); PG8_STAGE(PG8_SB(1, 1), cB + bhstep + kstep, voffB);
    PG8_WAIT_V(6); PG8_BAR;
    for (;;) {
        const bool has_next = S.next(ui + 1, nxt);
        const char* nA = has_next ? S.a_base(nxt) : cA; const char* nB = has_next ? S.b_base(nxt) : cB;
        if constexpr (GA) {
            if (has_next) S.a_offs(nxt, nvoA, RA, CA);
            else {
#pragma unroll
                for (int h = 0; h < 2; ++h)
#pragma unroll
                    for (int i = 0; i < 2; ++i) nvoA[h][i] = voA[h][i];
            }
        }
#pragma unroll 1
        for (int t = 0; t < nt; t += 2) {
            const bool last = (t == nt - 2);
            const char* a1 = cA + (size_t)(t + 1) * kstep;
            const char* a2 = last ? nA : cA + (size_t)(t + 2) * kstep; const char* b2 = last ? nB : cB + (size_t)(t + 2) * kstep;
            const char* a3 = a2 + kstep; const char* b3 = b2 + kstep;
            unsigned xo[2][2];
            if constexpr (GA) {
#pragma unroll
                for (int h = 0; h < 2; ++h)
#pragma unroll
                    for (int i = 0; i < 2; ++i) xo[h][i] = last ? nvoA[h][i] : voA[h][i];
            }
            PG8_LDB(B0, 0, 0); PG8_LDB(B1, 0, 1); PG8_SCHED; PG8_LDA(At, 0, 0); PG8_STA(PG8_SA(1, 1), a1, 1, voA);
            PG8_WAIT_V(8); PG8_WAIT_L(0); PG8_BAR; PG8_MMA(0, 0, At, B0); PG8_MMA(0, 1, At, B1); PG8_BAR; PG8_SCHED;
            PG8_LDA(At, 0, 1); PG8_STAGE(PG8_SB(0, 0), b2, voffB); PG8_STAGE(PG8_SB(0, 1), b2 + bhstep, voffB); PG8_STA(PG8_SA(0, 0), a2, 0, xo);
            PG8_WAIT_V(8); PG8_WAIT_L(0); PG8_BAR; PG8_MMA(1, 0, At, B0); PG8_MMA(1, 1, At, B1); PG8_BAR; PG8_SCHED;
            PG8_LDB(B0, 1, 0); PG8_LDB(B1, 1, 1); PG8_SCHED; PG8_LDA(At, 1, 0); PG8_STA(PG8_SA(0, 1), a2, 1, xo);
            PG8_WAIT_V(8); PG8_WAIT_L(0); PG8_BAR; PG8_MMA(0, 0, At, B0); PG8_MMA(0, 1, At, B1); PG8_BAR; PG8_SCHED;
            PG8_LDA(At, 1, 1); PG8_STAGE(PG8_SB(1, 0), b3, voffB); PG8_STAGE(PG8_SB(1, 1), b3 + bhstep, voffB); PG8_STA(PG8_SA(1, 0), a3, 0, xo);
            PG8_WAIT_V(8); PG8_WAIT_L(0); PG8_BAR; PG8_MMA(1, 0, At, B0); PG8_MMA(1, 1, At, B1); PG8_BAR; PG8_SCHED;
        }
        if (wr == 0) PG8_BAR;
        if constexpr (F8) asm volatile("s_nop 15\n\ts_nop 15" ::: "memory");
        { const int t2 = opq_tid() & 63; E(acc, cur, wr, wc, t2 & 15, t2 >> 4); }
        if (!has_next) break;
#pragma unroll
        for (int a = 0; a < 2; ++a)
#pragma unroll
            for (int b = 0; b < 2; ++b)
#pragma unroll
                for (int m = 0; m < 4; ++m)
#pragma unroll
                    for (int n = 0; n < 2; ++n) acc[a][b][m][n] = (f32x4){0.f, 0.f, 0.f, 0.f};
        cur = nxt; cA = nA; cB = nB; ++ui;
        if constexpr (GA) {
#pragma unroll
            for (int h = 0; h < 2; ++h)
#pragma unroll
                for (int i = 0; i < 2; ++i) voA[h][i] = nvoA[h][i];
        }
        if (wr == 1) PG8_BAR;
    }
    PG8_WAIT_V(0);
    PG8_BAR;
#undef PG8_SA
#undef PG8_SB
#undef PG8_STAGE
#undef PG8_STA
#undef PG8_LDA
#undef PG8_LDB
#undef PG8_MMA
#undef PG8_WAIT_V
#undef PG8_WAIT_L
#undef PG8_BAR
#undef PG8_SCHED
}
}

struct Args { const float* in[24]; float* out; unsigned char* ws; int ph_lo, ph_hi; };
enum { I_X = 0, I_C, I_CTX, I_CCTX, I_WMOD, I_BMOD, I_NMIX, I_NFFN, I_WIN, I_WOUT, I_CONVW, I_CONVB, I_GATEB, I_MNORM, I_QNORM, I_KNORM, I_RPB, I_RNORM, I_RW, I_RB, I_WUP, I_BUP, I_WDN, I_BDN };

typedef const __attribute__((address_space(4))) Args KArgs;
__device__ __forceinline__ KArgs& get_args() { unsigned long long p = (unsigned long long)__builtin_amdgcn_kernarg_segment_ptr(); asm volatile("" : "+s"(p)); return *(KArgs*)p; }
__device__ __forceinline__ size_t pxo(int row, int c) { return ((size_t)(c >> 6) * MT + row) * 64 + (c & 63); }
constexpr float QSC = 4.0f, QSC_INV = 1.0f / 4.0f;
static_assert(QSC == 4.0f, "the in-projection's rope epilogue hard-codes the QK8 scale");
constexpr float GSC = 4.0f, GSC_INV = 1.0f / 4.0f;
constexpr size_t WS_VTK8 = WS_QK2 + 36 * MiB;
__device__ __forceinline__ void unpack8f8(v2u r, float (&o)[8], float sc) {
    const auto a = __builtin_amdgcn_cvt_pk_f32_fp8((int)r.x, false), b = __builtin_amdgcn_cvt_pk_f32_fp8((int)r.x, true), c = __builtin_amdgcn_cvt_pk_f32_fp8((int)r.y, false), d = __builtin_amdgcn_cvt_pk_f32_fp8((int)r.y, true);
    o[0] = a[0] * sc; o[1] = a[1] * sc; o[2] = b[0] * sc; o[3] = b[1] * sc; o[4] = c[0] * sc; o[5] = c[1] * sc; o[6] = d[0] * sc; o[7] = d[1] * sc; }
__device__ __forceinline__ int chunk_row(int b, int cc) { return cc < 4 ? ML + b * CTXL + cc * 64 : b * SEQ + (cc - 4) * 64; }
__device__ __forceinline__ int vcu_of(int bx, int G) { return (G % 8 == 0) ? (bx % 8) * (G / 8) + bx / 8 : bx; }

template <int MODE> __device__ __forceinline__ int dest_row(int s) {
    if (MODE == 1) return s < 1024 ? s : (s < 1040 ? C_GATE + (s - 1024) : s - 16);
    if (MODE == 2) { const int j = s >> 1, bj = s & 1; return ((j >> 7) << 8) + (bj << 7) + (j & 127); }
    return s;
}
template <int MODE> __device__ __forceinline__ void transpose_item(const float* W, int K, int N, bf16* WT, LAS float* scr, int item, int lane) {
    const int nblk = (N + 63) / 64, kb = item / nblk, nb = item % nblk, k0 = 64 * kb, n0 = 64 * nb;
    const int n = n0 + lane; const bool ok = n < N;
    const float* src = W + (size_t)k0 * N + (ok ? n : 0);
#pragma unroll 16
    for (int i = 0; i < 64; ++i) { const float v = src[(size_t)i * N]; scr[i * 65 + lane] = ok ? v : 0.f; }
    LDS_WAIT(); asm volatile("" ::: "memory");
    const int c = lane & 7;
#pragma unroll
    for (int j = 0; j < 8; ++j) { const int nn = (lane >> 3) + 8 * j; const int s = n0 + nn; const LAS float* p = scr + (8 * c) * 65 + nn;
        v4u o; o.x = cvt_pk_bf16(p[0], p[65]); o.y = cvt_pk_bf16(p[130], p[195]); o.z = cvt_pk_bf16(p[260], p[325]); o.w = cvt_pk_bf16(p[390], p[455]);
        if (s < N) *(v4u*)(WT + (size_t)dest_row<MODE>(s) * K + k0 + 8 * c) = o; }
    LDS_WAIT(); asm volatile("" ::: "memory");
}
__device__ __forceinline__ void phase_prologue(LAS unsigned char* lds) {
    KArgs& A = get_args();
    const int tid = opq_tid(), lane = tid & 63, wave = __builtin_amdgcn_readfirstlane(tid >> 6);
    const int G = gridDim.x, gw = blockIdx.x * NWAVES + wave, NGW = G * NWAVES;
    unsigned char* ws = A.ws;
    {
        float* rope = (float*)(ws + WS_ROPE);
        for (int i = blockIdx.x * NTHR + tid; i < 192 * 16; i += G * NTHR) { const int pos = i >> 4, f = i & 15; const float p = (float)(pos < 128 ? pos : pos - 128);
            const float inv = powf(10000.0f, -(float)f / 16.0f); const float a = p * inv; rope[2 * i] = cosf(a); rope[2 * i + 1] = sinf(a); }
    }
    {
        LAS float* scr = (LAS float*)(lds + wave * 16640);
        constexpr int I_IN = 16 * 57, I_OUT = 16 * 16, I_UP = 16 * 32, I_DN = 16 * 16;
        constexpr int N_IN = DEPTH * I_IN, N_OUT = DEPTH * I_OUT, N_UP = DEPTH * NE * I_UP, N_DN = DEPTH * NE * I_DN, N_ALL = N_IN + N_OUT + N_UP + N_DN;
        const float* src = nullptr; bf16* wt = nullptr; int N = 0, n0 = 0, k0 = 0, mode = 0; bool ok = false;
        const float* nsrc = nullptr; bf16* nwt = nullptr; int nN = 0, nn0 = 0, nk0 = 0, nmode = 0; bool nok = false;
#define TDECODE(it_, src_, wt_, N_, n0_, k0_, mode_, ok_) do { int r = (it_), item; const float* W; \
            if (r < N_IN) { const int l2 = r / I_IN; item = r % I_IN; W = A.in[I_WIN] + (size_t)l2 * D * DIN; wt_ = (bf16*)(ws + WS_WIN + (size_t)l2 * NPX * D); N_ = DIN; mode_ = 1; } \
            else if ((r -= N_IN) < N_OUT) { const int l2 = r / I_OUT; item = r % I_OUT; W = A.in[I_WOUT] + (size_t)l2 * D * D; wt_ = (bf16*)(ws + WS_WOUT + (size_t)l2 * D * D); N_ = D; mode_ = 0; } \
            else if ((r -= N_OUT) < N_UP) { const int le = r / I_UP; item = r % I_UP; W = A.in[I_WUP] + (size_t)le * D * 2048; wt_ = (bf16*)(ws + WS_WUP + (size_t)le * 2048 * D); N_ = 2048; mode_ = 2; } \
            else { r -= N_UP; const int le = r / I_DN; item = r % I_DN; W = A.in[I_WDN] + (size_t)le * D * D; wt_ = (bf16*)(ws + WS_WDN + (size_t)le * D * D); N_ = D; mode_ = 3; } \
            const int nblk = (N_ + 63) / 64; k0_ = 64 * (item / nblk); n0_ = 64 * (item % nblk); ok_ = (n0_ + lane) < N_; src_ = W + (size_t)k0_ * N_ + (ok_ ? n0_ + lane : 0); } while (0)
        float cur[64], nxt[64];
        int it = gw;
        if (it < N_ALL) { TDECODE(it, src, wt, N, n0, k0, mode, ok);
#pragma unroll
            for (int i = 0; i < 64; ++i) cur[i] = __builtin_nontemporal_load(src + (size_t)i * N); }
        for (; it < N_ALL; it += NGW) {
            const bool has_next = it + NGW < N_ALL;
            if (has_next) { TDECODE(it + NGW, nsrc, nwt, nN, nn0, nk0, nmode, nok);
#pragma unroll
                for (int i = 0; i < 64; ++i) nxt[i] = __builtin_nontemporal_load(nsrc + (size_t)i * nN); }
#pragma unroll
            for (int i = 0; i < 64; ++i) scr[i * 65 + lane] = ok ? cur[i] : 0.f;
            LDS_WAIT(); asm volatile("" ::: "memory");
            const int c = lane & 7;
#pragma unroll
            for (int j = 0; j < 8; ++j) { const int nn = (lane >> 3) + 8 * j; const int sc_ = n0 + nn; const LAS float* p = scr + (8 * c) * 65 + nn;
                const int dr = mode == 1 ? dest_row<1>(sc_) : (mode == 2 ? dest_row<2>(sc_) : sc_);
                if (mode >= 0) { v2u o; o.x = pg8::pk4_fp8(p[0] * pg8::WSC, p[65] * pg8::WSC, p[130] * pg8::WSC, p[195] * pg8::WSC); o.y = pg8::pk4_fp8(p[260] * pg8::WSC, p[325] * pg8::WSC, p[390] * pg8::WSC, p[455] * pg8::WSC);
                    if (sc_ < N) *(v2u*)((unsigned char*)wt + (size_t)dr * D + k0 + 8 * c) = o; }
                else { v4u o; o.x = cvt_pk_bf16(p[0], p[65]); o.y = cvt_pk_bf16(p[130], p[195]); o.z = cvt_pk_bf16(p[260], p[325]); o.w = cvt_pk_bf16(p[390], p[455]);
                    if (sc_ < N) *(v4u*)(wt + (size_t)dr * D + k0 + 8 * c) = o; } }
            LDS_WAIT(); asm volatile("" ::: "memory");
            if (has_next) {
#pragma unroll
                for (int i = 0; i < 64; ++i) cur[i] = nxt[i];
                src = nsrc; wt = nwt; N = nN; n0 = nn0; k0 = nk0; mode = nmode; ok = nok; }
        }
#undef TDECODE
    }
    __syncthreads();
    {
        LAS float* sv = (LAS float*)lds;
        for (int i = tid; i < 5 * D; i += NTHR) { const int j = i >> 10, k = i & 1023; const float c = j < 4 ? A.in[I_C][j * D + k] : A.in[I_CCTX][k]; sv[i] = siluf_(c); }
        __syncthreads();
        float* mod = (float*)(ws + WS_MOD);
        LAS float* part = sv + 5 * D;
        for (int it = blockIdx.x; it < DEPTH * 96; it += G) {
            const int l2 = it / 96, n = (it % 96) * 64 + lane, kb = wave * 128;
            const float* w = A.in[I_WMOD] + (size_t)l2 * D * 6144 + (size_t)kb * 6144 + n;
            float a0 = 0.f, a1 = 0.f, a2 = 0.f, a3 = 0.f, a4 = 0.f;
#pragma unroll 16
            for (int k = 0; k < 128; ++k) { const float wv = w[(size_t)k * 6144]; a0 += sv[kb + k] * wv; a1 += sv[1024 + kb + k] * wv; a2 += sv[2048 + kb + k] * wv; a3 += sv[3072 + kb + k] * wv; a4 += sv[4096 + kb + k] * wv; }
            part[(wave * 5 + 0) * 64 + lane] = a0; part[(wave * 5 + 1) * 64 + lane] = a1; part[(wave * 5 + 2) * 64 + lane] = a2; part[(wave * 5 + 3) * 64 + lane] = a3; part[(wave * 5 + 4) * 64 + lane] = a4;
            __syncthreads();
            if (tid < 320) { const int j = tid >> 6, c = tid & 63; float t = 0.f;
#pragma unroll
                for (int w8 = 0; w8 < 8; ++w8) t += part[(w8 * 5 + j) * 64 + c];
                const int nn = (it % 96) * 64 + c;
                mod[((size_t)l2 * 5 + j) * 6144 + nn] = t + A.in[I_BMOD][l2 * 6144 + nn]; }
            __syncthreads();
        }
    }
    __syncthreads();
}

__device__ __forceinline__ void moe_offsets(int l, LAS int* lctl) {
    KArgs& A = get_args();
    __syncthreads();
    const int tid_ = opq_tid();
    if (tid_ < 64) {
        const int e = tid_ & 31;
        const unsigned* cnt = (const unsigned*)(A.ws + WS_CTL) + CW_CNT + l * 32 * 64;
        const int c = (int)__hip_atomic_load(cnt + e * 64, RLX_AGENT);
        const int t = (c + 255) >> 8;
        int incl = t;
#pragma unroll
        for (int o = 1; o < 32; o <<= 1) { const int v = shsrci(incl, (tid_ - o) & 63); if (e >= o) incl += v; }
        if (tid_ < 32) { lctl[e] = incl - t; lctl[64 + e] = c; if (e == 31) lctl[32] = incl;
            for (int k = 0; k < t; ++k) lctl[128 + incl - t + k] = e; }
    }
    __syncthreads();
}

template <int MODE> __device__ __forceinline__ void phase_norm1(int l, LAS unsigned char* lds) {
    KArgs& A = get_args();
    const int tid = opq_tid(), lane = tid & 63, wave = __builtin_amdgcn_readfirstlane(tid >> 6);
    const int G = gridDim.x, gw = blockIdx.x * NWAVES + wave, NGW = G * NWAVES;
    LAS int* lctl = (LAS int*)(lds + LDSCTL_OFF + 256);
    const bool comb = (MODE == 1) || (l > 0);
    const int lp = (MODE == 1) ? (DEPTH - 1) : (l - 1);
    if (comb) moe_offsets(lp, lctl);
    unsigned char* ws = A.ws;
    bf16* X = (bf16*)(ws + WS_X); const float* MOD = (const float*)(ws + WS_MOD);
    const bf16* Y = (const bf16*)(ws + WS_Y); const int* TS = (const int*)(ws + WS_TOKSLOT);
    bf16* HX = (bf16*)(ws + WS_ACT);
    const int mend = (MODE == 1) ? ML : MT;
    for (int m = gw; m < mend; m += NGW) {
        const int b = m < ML ? (m >> 13) : 4;
        f32x4 x[4];
        if (MODE == 0 && !comb) {
            const f32x4* xs = (const f32x4*)(m < ML ? A.in[I_X] + (size_t)m * D : A.in[I_CTX] + (size_t)(m - ML) * D) + lane;
            v2u* orow = (v2u*)(X + (size_t)m * D) + lane;
#pragma unroll
            for (int j = 0; j < 4; ++j) { x[j] = xs[64 * j]; v2u w; w.x = cvt_pk_bf16(x[j][0], x[j][1]); w.y = cvt_pk_bf16(x[j][2], x[j][3]); orow[64 * j] = w; }
        } else {
            const v2u* xr = (const v2u*)(X + (size_t)m * D) + lane;
#pragma unroll
            for (int j = 0; j < 4; ++j) { const v2u xv = xr[64 * j]; x[j] = (f32x4){bflo(xv.x), bfhi(xv.x), bflo(xv.y), bfhi(xv.y)}; }
        }
        if (comb) {
            const float* g2 = MOD + (size_t)(lp * 5 + b) * 6144 + 5 * 1024;
            f32x4 a[4];
#pragma unroll
            for (int j = 0; j < 4; ++j) a[j] = (f32x4){0.f, 0.f, 0.f, 0.f};
#pragma unroll
            for (int k = 0; k < 4; ++k) {
                const int slot = TS[m * 4 + k]; const int e = slot >> 20, rank = slot & 0xfffff;
                const float gt = ((const float*)(ws + WS_ROWGATE))[m * 4 + k] * pg8::YSC_INV;
                const size_t yrow = (size_t)lctl[e] * 256 + rank;
                const unsigned char* yb = (const unsigned char*)Y + ((size_t)(lane >> 4) * pg8::YROWS + yrow) * 64 + (lane & 15) * 4;
#pragma unroll
                for (int j = 0; j < 4; ++j) { const int y = *(const int*)(yb + (size_t)(4 * j) * pg8::YROWS * 64);
                    const auto lo = __builtin_amdgcn_cvt_pk_f32_fp8(y, false), hi = __builtin_amdgcn_cvt_pk_f32_fp8(y, true);
                    a[j][0] += gt * lo[0]; a[j][1] += gt * lo[1]; a[j][2] += gt * hi[0]; a[j][3] += gt * hi[1]; }
            }
#pragma unroll
            for (int j = 0; j < 4; ++j) { const f32x4 gv = *((const f32x4*)g2 + lane + 64 * j);
                x[j] = x[j] + gv * a[j]; }
            if (MODE == 1) { f32x4* orow = (f32x4*)(A.out + (size_t)m * D) + lane;
#pragma unroll
                for (int j = 0; j < 4; ++j) __builtin_nontemporal_store(x[j], orow + 64 * j); }
            else { v2u* orow = (v2u*)(X + (size_t)m * D) + lane;
#pragma unroll
                for (int j = 0; j < 4; ++j) { v2u w; w.x = cvt_pk_bf16(x[j][0], x[j][1]); w.y = cvt_pk_bf16(x[j][2], x[j][3]); orow[64 * j] = w; } }
        }
        if (MODE == 0) {
            float ss = 0.f;
#pragma unroll
            for (int j = 0; j < 4; ++j) ss += (x[j][0] * x[j][0] + x[j][1] * x[j][1]) + (x[j][2] * x[j][2] + x[j][3] * x[j][3]);
            const float r = rsqrtf(wave_sum(ss, lane) * (1.0f / D) + EPS);
            const float* mod = MOD + (size_t)(l * 5 + b) * 6144;
            const f32x4* nw = (const f32x4*)(A.in[I_NMIX] + l * D) + lane;
            unsigned* o = (unsigned*)((unsigned char*)HX + (size_t)m * D) + lane;
#pragma unroll
            for (int j = 0; j < 4; ++j) { const f32x4 w = nw[64 * j], sh = *((const f32x4*)mod + lane + 64 * j), sc = *((const f32x4*)(mod + 1024) + lane + 64 * j);
                const f32x4 y = x[j] * r * w * (sc + 1.0f) + sh;
                o[64 * j] = pg8::pk4_fp8(y[0], y[1], y[2], y[3]); }
        }
    }
}

__device__ __forceinline__ void phase_norm2(int l, LAS unsigned char* lds) {
    KArgs& A = get_args();
    const int tid = opq_tid(), lane = tid & 63, wave = __builtin_amdgcn_readfirstlane(tid >> 6), t = lane & 15, g = lane >> 4;
    const int G = gridDim.x;
    unsigned char* ws = A.ws;
    constexpr int WST = 1032;
    LAS bf16* WH = (LAS bf16*)lds;
    LAS float* A5 = (LAS float*)(lds + 66048);
    LAS float* SH5 = (LAS float*)(lds + 66048 + 20480);
    LAS float* PL = (LAS float*)(lds + 66048 + 40960);
    LAS float* SS = (LAS float*)(lds + 66048 + 40960 + 16384);
    LAS float* C5 = SS + 128;
    LAS int* TE = (LAS int*)(SS + 128 + 160);
    LAS float* TG = (LAS float*)(TE + 576);
    LAS int* TR = TE + 1152;
    LAS int* LCNT = TE + 1728;
    const float* MOD = (const float*)(ws + WS_MOD);
    { const float* rw = A.in[I_RW] + (size_t)l * D * NE;
      for (int i = tid; i < D * NE; i += NTHR) { const int k = i >> 5, e = i & 31; WH[e * WST + k] = f2bf(rw[i]); }
      const float* nw = A.in[I_NFFN] + l * D;
      for (int i = tid; i < 5 * D; i += NTHR) { const int b = i >> 10, k = i & 1023; const float* mod = MOD + (size_t)(l * 5 + b) * 6144 + 3 * 1024;
          A5[i] = nw[k] * (1.0f + mod[1024 + k]); SH5[i] = mod[k]; }
      if (tid < 64) LCNT[tid] = 0; }
    __syncthreads();
    for (int p = wave; p < 160; p += NWAVES) { const int b = p >> 5, e = p & 31; float acc = 0.f;
#pragma unroll
        for (int q = 0; q < 2; ++q) { float w8[8]; unpack8(*(const LAS v4u*)(WH + e * WST + 16 * lane + 8 * q), w8);
            const f32x4 s0 = *(const LAS f32x4*)(SH5 + b * 1024 + 16 * lane + 8 * q), s1 = *(const LAS f32x4*)(SH5 + b * 1024 + 16 * lane + 8 * q + 4);
            acc += (s0[0] * w8[0] + s0[1] * w8[1]) + (s0[2] * w8[2] + s0[3] * w8[3]) + (s1[0] * w8[4] + s1[1] * w8[5]) + (s1[2] * w8[6] + s1[3] * w8[7]); }
        acc = wave_sum(acc, lane);
        if (lane == 0) C5[p] = acc + A.in[I_RB][l * NE + e]; }
    __syncthreads();
    const bf16* X = (const bf16*)(ws + WS_X);
    unsigned char* TOK8 = (unsigned char*)(ws + WS_ACT);
    const int mend = (l == DEPTH - 1) ? ML : MT, ntile = mend >> 4;
    const int kw = wave * 128;
    f32x4 xc[4][2], xn[4][2];
    auto ldx = [&](int T, f32x4 (&d)[4][2]) {
        const bf16* xp = X + (size_t)(16 * T + t) * D + kw + 8 * g;
#pragma unroll
        for (int s2 = 0; s2 < 4; ++s2) { float xl[8]; unpack8(*(const v4u*)(xp + 32 * s2), xl);
            d[s2][0] = (f32x4){xl[0], xl[1], xl[2], xl[3]}; d[s2][1] = (f32x4){xl[4], xl[5], xl[6], xl[7]}; }
    };
    int T = blockIdx.x, it = 0;
    if (T < ntile) ldx(T, xc);
    for (; T < ntile; T += G, ++it) {
        if (T + G < ntile) ldx(T + G, xn);
        const int m0 = 16 * T, b = m0 < ML ? (m0 >> 13) : 4;
        float u[4][8]; float ss = 0.f;
        f32x4 acc[2] = {(f32x4){0.f, 0.f, 0.f, 0.f}, (f32x4){0.f, 0.f, 0.f, 0.f}};
#pragma unroll
        for (int s2 = 0; s2 < 4; ++s2) {
            const int k0 = kw + 32 * s2 + 8 * g;
            const f32x4 a0 = *(const LAS f32x4*)(A5 + b * 1024 + k0), a1 = *(const LAS f32x4*)(A5 + b * 1024 + k0 + 4);
            const f32x4 x0 = xc[s2][0], x1 = xc[s2][1];
            ss += (x0[0] * x0[0] + x0[1] * x0[1]) + (x0[2] * x0[2] + x0[3] * x0[3]) + (x1[0] * x1[0] + x1[1] * x1[1]) + (x1[2] * x1[2] + x1[3] * x1[3]);
#pragma unroll
            for (int j = 0; j < 4; ++j) { u[s2][j] = x0[j] * a0[j]; u[s2][4 + j] = x1[j] * a1[j]; }
            const v4u hi = pack8(u[s2]); float hf[8], lo[8]; unpack8(hi, hf);
#pragma unroll
            for (int j = 0; j < 8; ++j) lo[j] = u[s2][j] - hf[j];
            const bf16x8 fh = as_frag(hi), fl = as_frag(pack8(lo));
#pragma unroll
            for (int et = 0; et < 2; ++et) { const bf16x8 wf = *(const LAS bf16x8*)(WH + (16 * et + t) * WST + k0);
                acc[et] = mfma16(fh, wf, acc[et]); acc[et] = mfma16(fl, wf, acc[et]); }
        }
        ss += shx(ss, 16, lane); ss += shx(ss, 32, lane);
        if (g == 0) SS[wave * 16 + t] = ss;
#pragma unroll
        for (int et = 0; et < 2; ++et)
#pragma unroll
            for (int rg = 0; rg < 4; ++rg) PL[(wave * 16 + 4 * g + rg) * 32 + 16 * et + t] = acc[et][rg];
        __syncthreads();
        {
            float st = 0.f;
#pragma unroll
            for (int w8 = 0; w8 < 8; ++w8) st += SS[w8 * 16 + t];
            const float r = rsqrtf(st * (1.0f / D) + EPS);
            unsigned char* op = TOK8 + (size_t)(m0 + t) * D + kw + 8 * g;
#pragma unroll
            for (int s2 = 0; s2 < 4; ++s2) { const int k0 = kw + 32 * s2 + 8 * g;
                const f32x4 h0 = *(const LAS f32x4*)(SH5 + b * 1024 + k0), h1 = *(const LAS f32x4*)(SH5 + b * 1024 + k0 + 4);
                v2u w; w.x = pg8::pk4_fp8(r * u[s2][0] + h0[0], r * u[s2][1] + h0[1], r * u[s2][2] + h0[2], r * u[s2][3] + h0[3]);
                w.y = pg8::pk4_fp8(r * u[s2][4] + h1[0], r * u[s2][5] + h1[1], r * u[s2][6] + h1[2], r * u[s2][7] + h1[3]);
                *(v2u*)(op + 32 * s2) = w; }
        }
        {
            const int tk = 2 * wave + (lane >> 5), e = lane & 31;
            float st = 0.f, pl = 0.f;
#pragma unroll
            for (int w8 = 0; w8 < 8; ++w8) { st += SS[w8 * 16 + tk]; pl += PL[(w8 * 16 + tk) * 32 + e]; }
            const float logit = rsqrtf(st * (1.0f / D) + EPS) * pl + C5[b * 32 + e];
            unsigned kb = __float_as_uint(logit); kb = (kb & 0x80000000u) ? ~kb : (kb | 0x80000000u);
            unsigned key = (kb & ~31u) | (unsigned)(31 - e);
            float tv[4]; int te[4];
#pragma unroll
            for (int rdx = 0; rdx < 4; ++rdx) {
                unsigned bk = key;
#pragma unroll
                for (int o2 = 1; o2 < 32; o2 <<= 1) { const unsigned ok = (unsigned)shxi((int)bk, o2, lane); bk = ok > bk ? ok : bk; }
                te[rdx] = 31 - (int)(bk & 31u);
                tv[rdx] = shsrc(logit, (lane & 32) | te[rdx]);
                if (e == te[rdx]) key = 0u;
            }
            const float e1 = __expf(tv[1] - tv[0]), e2 = __expf(tv[2] - tv[0]), e3 = __expf(tv[3] - tv[0]);
            const float inv = 1.0f / (1.0f + e1 + e2 + e3);
            if (e < 4) {
                const int ek = e == 0 ? te[0] : (e == 1 ? te[1] : (e == 2 ? te[2] : te[3]));
                const float gk = (e == 0 ? 1.0f : (e == 1 ? e1 : (e == 2 ? e2 : e3))) * inv;
                const int slot = (it * 16 + tk) * 4 + e;
                TE[slot] = ek; TG[slot] = gk; TR[slot] = __hip_atomic_fetch_add(LCNT + ek, 1, __ATOMIC_RELAXED, __HIP_MEMORY_SCOPE_WORKGROUP);
            }
        }
        __syncthreads();
#pragma unroll
        for (int s2 = 0; s2 < 4; ++s2) { xc[s2][0] = xn[s2][0]; xc[s2][1] = xn[s2][1]; }
    }
    __syncthreads();
    if (tid < 32) { unsigned* cnt = (unsigned*)(ws + WS_CTL) + CW_CNT + l * 32 * 64; const int c = LCNT[tid]; LCNT[32 + tid] = c > 0 ? (int)__hip_atomic_fetch_add(cnt + tid * 64, (unsigned)c, RLX_AGENT) : 0; }
    __syncthreads();
    {
        int* ROWTOK = (int*)(ws + WS_ROWTOK); float* ROWGATE = (float*)(ws + WS_ROWGATE); int* TS = (int*)(ws + WS_TOKSLOT);
        for (int q = tid; q < it * 64; q += NTHR) {
            const int rd = q >> 6, tk = (q >> 2) & 15, k = q & 3, m = 16 * (blockIdx.x + rd * G) + tk;
            const int ek = TE[q]; const int rank = LCNT[32 + ek] + TR[q];
            ROWTOK[(size_t)ek * CAP + rank] = m; ROWGATE[m * 4 + k] = TG[q]; TS[m * 4 + k] = (ek << 20) | rank; }
    }
}

__device__ __forceinline__ float incl_prefix_sum(float v, int lane) {
#pragma unroll
    for (int o = 1; o < 64; o <<= 1) { const float t = shsrc(v, (lane - o) & 63); if (lane >= o) v += t; }
    return v;
}
__device__ __forceinline__ float incl_suffix_sum(float v, int lane) {
#pragma unroll
    for (int o = 1; o < 64; o <<= 1) { const float t = shsrc(v, (lane + o) & 63); if (lane + o < 64) v += t; }
    return v;
}
__device__ __forceinline__ float incl_prefix_max(float v, int lane) {
#pragma unroll
    for (int o = 1; o < 64; o <<= 1) { const float t = shsrc(v, (lane - o) & 63); if (lane >= o) v = fmaxf(v, t); }
    return v;
}
__device__ __forceinline__ float incl_suffix_max(float v, int lane) {
#pragma unroll
    for (int o = 1; o < 64; o <<= 1) { const float t = shsrc(v, (lane + o) & 63); if (lane + o < 64) v = fmaxf(v, t); }
    return v;
}
__device__ __forceinline__ float ret_log_gamma(int h, int dir) { const int e = dir + 2 * h; const float t[8] = {-3.174869831e-02f, -1.574835697e-02f, -7.843177461e-03f, -3.913899321e-03f, -1.955034836e-03f, -9.770396478e-04f, -4.884004981e-04f, -2.441704322e-04f};
    float r = t[0];
#pragma unroll
    for (int i = 1; i < 8; ++i) r = (e == i) ? t[i] : r;
    return r; }

__device__ __forceinline__ void store_tr8(bf16* dst  , const unsigned (&w)[8][4]) {
#pragma unroll
    for (int c = 0; c < 8; ++c) *(v4u*)(dst + c * 8) = (v4u){w[c][0], w[c][1], w[c][2], w[c][3]};
}
__device__ __forceinline__ void phase_prepass(int l) {
    KArgs& A = get_args();
    const int tid = opq_tid(), lane = tid & 63, wave = __builtin_amdgcn_readfirstlane(tid >> 6);
    unsigned char* ws = A.ws;
    const bf16* PX = (const bf16*)(ws + WS_PX); const float* ROPE = (const float*)(ws + WS_ROPE);
    bf16* KNH = (bf16*)(ws + WS_KN); bf16* QK2 = (bf16*)(ws + WS_QK2); bf16* VTB = (bf16*)(ws + WS_VTB);
    const int NWI = (MT / 32) * 4 * 2;
    for (int wi = blockIdx.x * NWAVES + wave; wi < NWI; wi += gridDim.x * NWAVES) {
        const int kind = 3 + (wi & 1), ug = wi >> 1, g = ug & 3, u = ug >> 2;
        const int row0 = u * 32;
        int rows[8];
#pragma unroll
        for (int k = 0; k < 8; ++k) rows[k] = row0 + (k < 4 ? 4 * g + k : 16 + 4 * g + (k - 4));
        if (kind == 0) {
            const int hp = lane, part = lane & 7; const float* knw = A.in[I_KNORM] + l * 64 + 8 * part;
            float kw[8];
#pragma unroll
            for (int q = 0; q < 8; ++q) kw[q] = knw[q];
#pragma unroll
            for (int k = 0; k < 8; ++k) { float x[8]; unpack8(*(const v4u*)(PX + pxo(rows[k], C_NK + hp * 8)), x);
                float ss = 0.f;
#pragma unroll
                for (int q = 0; q < 8; ++q) ss += x[q] * x[q];
                ss += shx(ss, 1, lane); ss += shx(ss, 2, lane); ss += shx(ss, 4, lane);
                const float rn = rsqrtf(ss * (1.0f / 64.0f) + EPS);
#pragma unroll
                for (int q = 0; q < 8; ++q) x[q] *= rn * kw[q];
                *(v4u*)(KNH + ((size_t)(hp >> 3) * MT + rows[k]) * 64 + 8 * part) = pack8(x); }
        } else if (kind <= 2) {
            const int cg = (kind - 1) * 64 + lane, ch = cg * 8;
            const int src = ch < 512 ? C_NV + ch : (ch < 768 ? C_MV + (ch - 512) : C_RV + (ch - 768));
            v4u raw[8];
#pragma unroll
            for (int k = 0; k < 8; ++k) raw[k] = *(const v4u*)(PX + pxo(rows[k], src));
            unsigned w[8][4];
#pragma unroll
            for (int c = 0; c < 8; ++c)
#pragma unroll
                for (int q = 0; q < 4; ++q) { const unsigned lo = raw[2 * q][c >> 1], hi = raw[2 * q + 1][c >> 1];
                    w[c][q] = (c & 1) ? __builtin_amdgcn_perm(hi, lo, 0x07060302u) : __builtin_amdgcn_perm(hi, lo, 0x05040100u); }
            store_tr8(VTB + ((((size_t)u * VTB_H + (ch >> 6)) * 4 + g) * 64 + (ch & 63)) * 8, w);
        } else {
            const bool isk = lane >= 32; const int cg = lane & 31, hh = cg >> 3, part = cg & 7;
            const float sc = isk ? 0.125f : 1.0f;
            float o[8][8];
            if (kind == 3) {
                const int ch = (isk ? 256 : 0) + cg * 8;
                const float* cw = A.in[I_CONVW] + (size_t)l * 3 * 512 + ch; const float* cb = A.in[I_CONVB] + l * 512 + ch;
                float w0[8], w1[8], w2[8], bb[8];
#pragma unroll
                for (int q = 0; q < 8; ++q) { w0[q] = cw[q]; w1[q] = cw[512 + q]; w2[q] = cw[1024 + q]; bb[q] = cb[q]; }
#pragma unroll
                for (int half = 0; half < 2; ++half) {
                    const int r0 = row0 + 16 * half + 4 * g;
                    const int ts0 = r0 < ML ? (r0 & (SEQ - 1)) : ((r0 - ML) & (CTXL - 1)), slen = r0 < ML ? SEQ : CTXL;
                    float x[6][8];
#pragma unroll
                    for (int k = 0; k < 6; ++k) { const int ts = ts0 + k - 1;
                        if (ts >= 0 && ts < slen) unpack8(*(const v4u*)(PX + pxo(r0 + k - 1, C_MQ + ch)), x[k]); else {
#pragma unroll
                            for (int q = 0; q < 8; ++q) x[k][q] = 0.f; } }
#pragma unroll
                    for (int k = 0; k < 4; ++k)
#pragma unroll
                        for (int q = 0; q < 8; ++q) o[4 * half + k][q] = siluf_(bb[q] + w0[q] * x[k][q] + w1[q] * x[k + 1][q] + w2[q] * x[k + 2][q]) * sc;
                }
            } else {
                if (isk) {
#pragma unroll
                    for (int k = 0; k < 8; ++k) unpack8f8(*(const v2u*)((const unsigned char*)QK2 + ((size_t)(12 + hh) * MT + rows[k]) * 64 + 8 * part), o[k], QSC_INV);
                }
            }
            const int slot = (kind == 3 ? 0 : 8) + (isk ? 4 : 0) + hh;
#pragma unroll
            for (int k = 0; k < 8 && kind == 3; ++k) { v2u w8; w8.x = pg8::pk4_fp8(o[k][0] * QSC, o[k][1] * QSC, o[k][2] * QSC, o[k][3] * QSC); w8.y = pg8::pk4_fp8(o[k][4] * QSC, o[k][5] * QSC, o[k][6] * QSC, o[k][7] * QSC);
                *(v2u*)((unsigned char*)QK2 + ((size_t)slot * MT + rows[k]) * 64 + 8 * part) = w8; }
            if (isk) { unsigned char* vt = ws + WS_VTK8 + ((((size_t)u * 8 + (kind == 3 ? 0 : 4) + hh) * 4 + g) * 64 + 8 * part) * 8;
#pragma unroll
                for (int c = 0; c < 8; ++c) { v2u w8; w8.x = pg8::pk4_fp8(o[0][c] * QSC, o[1][c] * QSC, o[2][c] * QSC, o[3][c] * QSC); w8.y = pg8::pk4_fp8(o[4][c] * QSC, o[5][c] * QSC, o[6][c] * QSC, o[7][c] * QSC);
                    *(v2u*)(vt + c * 8) = w8; } }
        }
    }
}

template <int TYPE> __device__ __forceinline__ void unit_stats2(int l, LAS unsigned char* lds, int b, int cc, int h) {
    KArgs& A = get_args();
    const int tid = opq_tid(), lane = tid & 63, wave = __builtin_amdgcn_readfirstlane(tid >> 6), fr = lane & 15, g = lane >> 4;
    unsigned char* ws = A.ws;
    const bf16* PX = (const bf16*)(ws + WS_PX); const bf16* VTB = (const bf16*)(ws + WS_VTB);
    LAS float* EW = (LAS float*)(lds + wave * 512);
    const int row0 = chunk_row(b, cc), seq0 = (b * 4 + h) * 2, blk0 = row0 >> 5;
    float* MLOC = (float*)(ws + WS_MISC); float* BTOT = MLOC + NSEQ * NCH;
    if (TYPE == 0) {
        const bf16* gp = PX + pxo(row0 + lane, C_GATE); const float* gb = A.in[I_GATEB] + l * 16;
#pragma unroll
        for (int dir = 0; dir < 2; ++dir) {
            const float li = bf2f(gp[dir * 8 + h]) + gb[dir * 8 + h];
            const float lf = logsigmoidf_(bf2f(gp[dir * 8 + 4 + h]) + gb[dir * 8 + 4 + h]);
            const float cum = dir == 0 ? incl_prefix_sum(lf, lane) : incl_suffix_sum(lf, lane);
            const float btot = shsrc(cum, dir == 0 ? 63 : 0);
            const float wl = btot - cum + li;
            const float ml = wave_max(wl, lane);
            EW[dir * 64 + lane] = __expf(wl - ml);
            if (lane == 0) { MLOC[(seq0 + dir) * NCH + cc] = ml; BTOT[(seq0 + dir) * NCH + cc] = btot; }
        }
    } else {
#pragma unroll
        for (int dir = 0; dir < 2; ++dir) EW[dir * 64 + lane] = __expf(ret_log_gamma(h, dir) * (float)(dir == 0 ? 63 - lane : lane));
    }
    bf16x8 vf[2][4];
#pragma unroll
    for (int ks = 0; ks < 2; ++ks)
#pragma unroll
        for (int et = 0; et < 4; ++et) vf[ks][et] = as_frag(*(const v4u*)(VTB + ((((size_t)(blk0 + ks) * VTB_H + 8 + 4 * TYPE + h) * 4 + g) * 64 + 16 * et + fr) * 8));
    v2u kraw[2][4];
#pragma unroll
    for (int ks = 0; ks < 2; ++ks)
#pragma unroll
        for (int dt = 0; dt < 4; ++dt) kraw[ks][dt] = *(const v2u*)(ws + WS_VTK8 + ((((size_t)(blk0 + ks) * 8 + 4 * TYPE + h) * 4 + g) * 64 + 16 * dt + fr) * 8);
#pragma unroll
    for (int dir = 0; dir < 2; ++dir) {
        f32x4 acc[4][4];
#pragma unroll
        for (int et = 0; et < 4; ++et)
#pragma unroll
            for (int dt = 0; dt < 4; ++dt) acc[et][dt] = (f32x4){0.f, 0.f, 0.f, 0.f};
        float nsum[4] = {0.f, 0.f, 0.f, 0.f};
#pragma unroll
        for (int ks = 0; ks < 2; ++ks) {
            const f32x4 e0 = *(const LAS f32x4*)(EW + dir * 64 + 32 * ks + 4 * g), e1 = *(const LAS f32x4*)(EW + dir * 64 + 32 * ks + 16 + 4 * g);
            const float ew[8] = {e0[0], e0[1], e0[2], e0[3], e1[0], e1[1], e1[2], e1[3]};
#pragma unroll
            for (int dt = 0; dt < 4; ++dt) { float k[8]; unpack8f8(kraw[ks][dt], k, QSC_INV);
#pragma unroll
                for (int i = 0; i < 8; ++i) k[i] *= ew[i];
                const v4u pk = pack8(k); const bf16x8 kfr = as_frag(pk);
                if (TYPE == 0) { float kr[8]; unpack8(pk, kr); nsum[dt] += ((kr[0] + kr[1]) + (kr[2] + kr[3])) + ((kr[4] + kr[5]) + (kr[6] + kr[7])); }
#pragma unroll
                for (int et = 0; et < 4; ++et) acc[et][dt] = mfma16(vf[ks][et], kfr, acc[et][dt]); }
        }
        float* CL = (float*)(ws + (TYPE == 0 ? WS_CLOC : WS_RLOC)) + ((size_t)(seq0 + dir) * NCH + cc) * 4096;
#pragma unroll
        for (int et = 0; et < 4; ++et)
#pragma unroll
            for (int dt = 0; dt < 4; ++dt)
#pragma unroll
                for (int r = 0; r < 4; ++r) CL[(16 * et + 4 * g + r) * 64 + 16 * dt + fr] = acc[et][dt][r];
        if (TYPE == 0) {
#pragma unroll
            for (int dt = 0; dt < 4; ++dt) { float n = nsum[dt]; n += shx(n, 16, lane); n += shx(n, 32, lane);
                if (g == 0) ((float*)(ws + WS_NLOC))[((size_t)(seq0 + dir) * NCH + cc) * 64 + 16 * dt + fr] = n; }
        }
    }
}

#define NA_LOADSTEP(st, KF, VF) do { const int _t0 = (st) < nloc ? b * SEQ + (rs + ((st) >> 1)) * 64 + 32 * ((st) & 1) : ML + b * CTXL + 32 * ((st) - nloc); \
    _Pragma("unroll") for (int _t = 0; _t < 2; ++_t) _Pragma("unroll") for (int _s = 0; _s < 2; ++_s) KF[_t][_s] = *(const v4u*)(KN + ((size_t)h * MT + _t0 + 16 * _t + fr) * 64 + 32 * _s + 8 * g); \
    _Pragma("unroll") for (int _e = 0; _e < 4; ++_e) VF[_e] = *(const v4u*)(VTB + ((((size_t)(_t0 >> 5) * VTB_H + h) * 4 + g) * 64 + 16 * _e + fr) * 8); } while (0)
__device__ __forceinline__ void unit_na2(int l, LAS unsigned char* lds, int b, int r, int h, bool ctxq) {
    KArgs& A = get_args();
    const int tid = opq_tid(), lane = tid & 63, wave = __builtin_amdgcn_readfirstlane(tid >> 6), fr = lane & 15, g = lane >> 4;
    unsigned char* ws = A.ws;
    const bf16* PX = (const bf16*)(ws + WS_PX); const bf16* KN = (const bf16*)(ws + WS_KN); const bf16* VTB = (const bf16*)(ws + WS_VTB);
    LAS float* RPB = (LAS float*)(lds + wave * 6144) + 128;
    const int qrow0 = ctxq ? ML + b * CTXL + r * 64 : b * SEQ + r * 64;
    const int nloc = ctxq ? 0 : 16, nsteps = nloc + 8;
    const int rs = r - 4 < 0 ? 0 : (r - 4 > 120 ? 120 : r - 4);
    constexpr float LOG2E = 1.4426950408889634f;
    float bmax = 0.f;
    if (!ctxq) { const float* rp = A.in[I_RPB] + ((size_t)l * 8 + h) * 465; for (int i = lane; i < 465; i += 64) { const float t = rp[i] * LOG2E; RPB[i] = t; bmax = fmaxf(bmax, fabsf(t)); } bmax = wave_max(bmax, lane); }
    const float knmax = wave_max(fabsf(A.in[I_KNORM][l * 64 + lane]), lane) * 8.0f;
    bf16x8 qf[4][2]; float nm[4];
    {
        const float* qn = A.in[I_QNORM] + l * 64;
#pragma unroll
        for (int qt = 0; qt < 4; ++qt) {
            float q[2][8]; float ss = 0.f;
#pragma unroll
            for (int s = 0; s < 2; ++s) { unpack8(*(const v4u*)(PX + pxo(qrow0 + 16 * qt + fr, C_NQ + h * 64 + 32 * s + 8 * g)), q[s]);
#pragma unroll
                for (int i = 0; i < 8; ++i) ss += q[s][i] * q[s][i]; }
            ss += shx(ss, 16, lane); ss += shx(ss, 32, lane);
            const float rn = rsqrtf(ss * (1.0f / 64.0f) + EPS) * (0.125f * LOG2E);
            float s2 = 0.f;
#pragma unroll
            for (int s = 0; s < 2; ++s) {
#pragma unroll
                for (int i = 0; i < 8; ++i) { q[s][i] *= rn * qn[32 * s + 8 * g + i]; s2 += q[s][i] * q[s][i]; }
                qf[qt][s] = as_frag(pack8(q[s])); }
            s2 += shx(s2, 16, lane); s2 += shx(s2, 32, lane);
            nm[qt] = -(sqrtf(s2) * knmax * 1.01f + bmax);
        }
    }
    float ls[4]; f32x4 OT[4][4];
#pragma unroll
    for (int qt = 0; qt < 4; ++qt) { ls[qt] = 0.f;
#pragma unroll
        for (int et = 0; et < 4; ++et) OT[qt][et] = (f32x4){0.f, 0.f, 0.f, 0.f}; }
    v4u kc_[2][2], vc_[4], kn_[2][2], vn_[4];
    NA_LOADSTEP(0, kc_, vc_);
    for (int st = 0; st < nsteps; ++st) {
        if (st + 1 < nsteps) NA_LOADSTEP(st + 1, kn_, vn_);
        const bool local = st < nloc;
        const int hh = st & 1, dr = rs + (st >> 1) - r + 7;
#pragma unroll
        for (int qt = 0; qt < 4; ++qt) {
            const bool act = !local || (hh == 0 ? qt <= 2 : qt >= 1);
            if (act) {
                f32x4 sT[2];
                const f32x4 init = (f32x4){nm[qt], nm[qt], nm[qt], nm[qt]};
                const bool dead0 = local && qt == 2 && hh == 0, dead1 = local && qt == 1 && hh == 1;
#pragma unroll
                for (int t = 0; t < 2; ++t) { if ((t == 0 && dead0) || (t == 1 && dead1)) continue; sT[t] = mfma16(as_frag(kc_[t][0]), qf[qt][0], init); sT[t] = mfma16(as_frag(kc_[t][1]), qf[qt][1], sT[t]); }
                float p[8];
                if (local) {
                    const int qc = 16 * qt + fr; const int cs = qc - 8 < 0 ? 0 : (qc - 8 > 48 ? 48 : qc - 8);
                    const int kc0 = 32 * hh + 4 * g;
                    const LAS float* bp = RPB + dr * 31 + (kc0 - qc + 15);
                    const int d0 = kc0 - cs;
                    float bia[8];
#pragma unroll
                    for (int t = 0; t < 2; ++t)
#pragma unroll
                        for (int rg = 0; rg < 4; ++rg) bia[4 * t + rg] = bp[16 * t + rg];
                    asm volatile("" : "+v"(bia[0]), "+v"(bia[1]), "+v"(bia[2]), "+v"(bia[3]), "+v"(bia[4]), "+v"(bia[5]), "+v"(bia[6]), "+v"(bia[7]));
#pragma unroll
                    for (int t = 0; t < 2; ++t) {
                        if ((t == 0 && dead0) || (t == 1 && dead1)) {
#pragma unroll
                            for (int rg = 0; rg < 4; ++rg) p[4 * t + rg] = 0.f;
                        } else {
#pragma unroll
                            for (int rg = 0; rg < 4; ++rg) { const bool valid = (unsigned)(d0 + 16 * t + rg) < 16u;
                                p[4 * t + rg] = valid ? __builtin_amdgcn_exp2f(sT[t][rg] + bia[4 * t + rg]) : 0.f; }
                        }
                    }
                } else {
#pragma unroll
                    for (int t = 0; t < 2; ++t)
#pragma unroll
                        for (int rg = 0; rg < 4; ++rg) p[4 * t + rg] = __builtin_amdgcn_exp2f(sT[t][rg]);
                }
                ls[qt] += ((p[0] + p[1]) + (p[2] + p[3])) + ((p[4] + p[5]) + (p[6] + p[7]));
                const bf16x8 pf = as_frag(pack8(p));
#pragma unroll
                for (int et = 0; et < 4; ++et) OT[qt][et] = mfma16(as_frag(vc_[et]), pf, OT[qt][et]);
            }
        }
#pragma unroll
        for (int t = 0; t < 2; ++t)
#pragma unroll
            for (int s = 0; s < 2; ++s) kc_[t][s] = kn_[t][s];
#pragma unroll
        for (int e = 0; e < 4; ++e) vc_[e] = vn_[e];
    }
    bf16* MIX = (bf16*)(ws + WS_MIX);
#pragma unroll
    for (int qt = 0; qt < 4; ++qt) {
        float s = ls[qt]; s += shx(s, 16, lane); s += shx(s, 32, lane);
        const float inv = 1.0f / s;
        unsigned char* op = (unsigned char*)MIX + (size_t)(qrow0 + 16 * qt + fr) * D + 256 + h * 64 + 4 * g;
#pragma unroll
        for (int et = 0; et < 4; ++et) { const f32x4 o = OT[qt][et] * inv; *(unsigned*)(op + 16 * et) = pg8::pk4_fp8(o[0], o[1], o[2], o[3]); }
    }
}

__device__ __forceinline__ void phase_stats(int l, LAS unsigned char* lds) {
    const int wave_ = __builtin_amdgcn_readfirstlane(opq_tid() >> 6);
    for (int v = blockIdx.x * NWAVES + wave_; v < 2 * NB * NCH * 4; v += gridDim.x * NWAVES) {
        const int ty = v / (NB * NCH * 4), r = v % (NB * NCH * 4), h = r & 3, cc = (r >> 2) % NCH, b = (r >> 2) / NCH;
        if (ty == 0) unit_stats2<0>(l, lds, b, cc, h); else unit_stats2<1>(l, lds, b, cc, h);
    }
}

__device__ __forceinline__ int chain_cc(int dir, int p) { return dir ? (p < 4 ? 3 - p : 135 - p) : p; }
constexpr int NA_EARLY = 1024;
__device__ __forceinline__ void unit_na2(int l, LAS unsigned char* lds, int b, int r, int h, bool ctxq);
__device__ __forceinline__ void phase_scan(int l, LAS unsigned char* lds) {
    KArgs& A = get_args();
    unsigned char* ws = A.ws;
    const int tid = opq_tid(), wave = __builtin_amdgcn_readfirstlane(tid >> 6);
    if (wave >= 4) {
        const int v = vcu_of((int)blockIdx.x, (int)gridDim.x) * 4 + (wave - 4);
        if (gridDim.x * 4 == NA_EARLY) unit_na2(l, lds, v >> 10, (v >> 3) & 127, v & 7, false);
        return;
    }
    const float* MLOC = (const float*)(ws + WS_MISC); const float* BTOT = MLOC + NSEQ * NCH; float* MPREV = (float*)(ws + WS_MISC) + 2 * NSEQ * NCH;
    const float* CL = (const float*)(ws + WS_CLOC); bf16* CP = (bf16*)(ws + WS_CPREV);
    const float* RL = (const float*)(ws + WS_RLOC); bf16* RP = (bf16*)(ws + WS_RPREV);
    const float* NL = (const float*)(ws + WS_NLOC); float* NP = (float*)(ws + WS_NPREV);
    const int HT = gridDim.x * 256;
    for (int idx0 = blockIdx.x * 256 + tid; idx0 < NSEQ * 4096; idx0 += 2 * HT) {
        int seq[2], el[2], dir[2]; float gch[2], C[2], R[2], m[2], n[2]; size_t base[2]; bool on[2], hasn[2];
#pragma unroll
        for (int c = 0; c < 2; ++c) { const int idx = idx0 + c * HT; on[c] = idx < NSEQ * 4096; const int ii = on[c] ? idx : idx0;
            seq[c] = ii >> 12; el[c] = ii & 4095; dir[c] = seq[c] & 1; gch[c] = __expf(64.0f * ret_log_gamma((seq[c] >> 1) & 3, dir[c]));
            C[c] = 0.f; R[c] = 0.f; m[c] = 0.f; n[c] = 0.f; base[c] = (size_t)seq[c] * NCH * 4096 + el[c]; hasn[c] = el[c] < 64; }
        for (int p0 = 0; p0 < NCH; p0 += 6) {
            float cl[2][6], rl[2][6], ml[2][6], bt[2][6], nl[2][6];
#pragma unroll
            for (int c = 0; c < 2; ++c)
#pragma unroll
                for (int q = 0; q < 6; ++q) { const int cc = chain_cc(dir[c], p0 + q); cl[c][q] = CL[base[c] + (size_t)cc * 4096]; rl[c][q] = RL[base[c] + (size_t)cc * 4096];
                    ml[c][q] = MLOC[seq[c] * NCH + cc]; bt[c][q] = BTOT[seq[c] * NCH + cc]; nl[c][q] = hasn[c] ? NL[((size_t)seq[c] * NCH + cc) * 64 + el[c]] : 0.f; }
#pragma unroll
            for (int c = 0; c < 2; ++c)
#pragma unroll
                for (int q = 0; q < 6; ++q) { const int cc = chain_cc(dir[c], p0 + q); const size_t o = base[c] + (size_t)cc * 4096;
                    if (on[c]) { CP[o] = f2bf(C[c]); RP[o] = f2bf(R[c]);
                        if (hasn[c]) NP[((size_t)seq[c] * NCH + cc) * 64 + el[c]] = n[c];
                        if (el[c] == 0) MPREV[seq[c] * NCH + cc] = m[c]; }
                    const float mn = fmaxf(bt[c][q] + m[c], ml[c][q]), a = __expf(bt[c][q] + m[c] - mn), g = __expf(ml[c][q] - mn);
                    C[c] = a * C[c] + g * cl[c][q]; n[c] = a * n[c] + g * nl[c][q]; m[c] = mn; R[c] = gch[c] * R[c] + rl[c][q]; }
        }
    }
}

template <int TYPE> __device__ __forceinline__ void unit_out2(int l, LAS unsigned char* lds, int b, int cc, int h) {
    KArgs& A = get_args();
    const int tid = opq_tid(), lane = tid & 63, wave = __builtin_amdgcn_readfirstlane(tid >> 6), fr = lane & 15, g = lane >> 4;
    unsigned char* ws = A.ws;
    const bf16* PX = (const bf16*)(ws + WS_PX); const bf16* QK2 = (const bf16*)(ws + WS_QK2); const bf16* VTB = (const bf16*)(ws + WS_VTB);
    LAS float* VEC = (LAS float*)(lds + wave * 6144 + 4096);
    const int row0 = chunk_row(b, cc), seq0 = (b * 4 + h) * 2;
    float mprev[2] = {0.f, 0.f};
    if (TYPE == 0) {
        const bf16* gp = PX + pxo(row0 + lane, C_GATE); const float* gb = A.in[I_GATEB] + l * 16;
#pragma unroll
        for (int dir = 0; dir < 2; ++dir) {
            const float li = bf2f(gp[dir * 8 + h]) + gb[dir * 8 + h];
            const float lf = logsigmoidf_(bf2f(gp[dir * 8 + 4 + h]) + gb[dir * 8 + 4 + h]);
            const float cum = dir == 0 ? incl_prefix_sum(lf, lane) : incl_suffix_sum(lf, lane);
            const float u = li - cum;
            const float pm = dir == 0 ? incl_prefix_max(u, lane) : incl_suffix_max(u, lane);
            VEC[(dir * 3 + 0) * 64 + lane] = cum; VEC[(dir * 3 + 1) * 64 + lane] = u; VEC[(dir * 3 + 2) * 64 + lane] = pm;
            mprev[dir] = ((const float*)(ws + WS_MISC))[2 * NSEQ * NCH + (seq0 + dir) * NCH + cc];
        }
    }
    bf16x8 kf[4][2];
#pragma unroll
    for (int lt = 0; lt < 4; ++lt)
#pragma unroll
        for (int s = 0; s < 2; ++s) { float kk[8]; unpack8f8(*(const v2u*)((const unsigned char*)QK2 + ((size_t)(8 * TYPE + 4 + h) * MT + row0 + 16 * lt + fr) * 64 + 32 * s + 8 * g), kk, QSC_INV); kf[lt][s] = as_frag(pack8(kk)); }
    bf16x8 vf[2][4];
    { const int hh = (TYPE == 0 ? 8 : 12) + h;
#pragma unroll
      for (int ks = 0; ks < 2; ++ks)
#pragma unroll
        for (int et = 0; et < 4; ++et) vf[ks][et] = as_frag(*(const v4u*)(VTB + ((((size_t)((row0 >> 5) + ks) * VTB_H + hh) * 4 + g) * 64 + 16 * et + fr) * 8)); }
    const float* nw = A.in[TYPE == 0 ? I_MNORM : I_RNORM] + l * 64;
    bf16* MIX = (bf16*)(ws + WS_MIX);
#pragma unroll 1
    for (int jt = 0; jt < 4; ++jt) {
        const int j = 16 * jt + fr;
        bf16x8 qf[2]; float qnp[2] = {0.f, 0.f};
#pragma unroll
        for (int s = 0; s < 2; ++s) { float qr[8]; unpack8f8(*(const v2u*)((const unsigned char*)QK2 + ((size_t)(8 * TYPE + h) * MT + row0 + j) * 64 + 32 * s + 8 * g), qr, QSC_INV); qf[s] = as_frag(pack8(qr));
            if (TYPE == 0) {
#pragma unroll
                for (int dir = 0; dir < 2; ++dir) { const float* np_ = (const float*)(ws + WS_NPREV) + ((size_t)(seq0 + dir) * NCH + cc) * 64 + 32 * s + 8 * g;
                    const f32x4 n0 = *(const f32x4*)np_, n1 = *(const f32x4*)(np_ + 4);
                    qnp[dir] += (qr[0] * n0[0] + qr[1] * n0[1]) + (qr[2] * n0[2] + qr[3] * n0[3]) + (qr[4] * n1[0] + qr[5] * n1[1]) + (qr[6] * n1[2] + qr[7] * n1[3]); } }
        }
        f32x4 hs[4];
#pragma unroll
        for (int et = 0; et < 4; ++et) hs[et] = (f32x4){0.f, 0.f, 0.f, 0.f};
#pragma unroll
        for (int dir = 0; dir < 2; ++dir) {
            const float lg = ret_log_gamma(h, dir);
            float cj = 0.f, mq = 0.f, aw;
            if (TYPE == 0) { cj = VEC[(dir * 3 + 0) * 64 + j]; const float il = cj + mprev[dir]; mq = fmaxf(cj + VEC[(dir * 3 + 2) * 64 + j], il); aw = __expf(il - mq); }
            else aw = __expf(lg * (float)(dir == 0 ? j + 1 : 64 - j));
            float sw[4][4]; float den = 0.f;
#pragma unroll
            for (int lt = 0; lt < 4; ++lt) {
                const bool act = dir == 0 ? (lt <= jt) : (lt >= jt);
                if (act) {
                    f32x4 sT = mfma16(kf[lt][0], qf[0], (f32x4){0.f, 0.f, 0.f, 0.f}); sT = mfma16(kf[lt][1], qf[1], sT);
                    f32x4 uv = (f32x4){0.f, 0.f, 0.f, 0.f};
                    if (TYPE == 0) uv = *(const LAS f32x4*)(VEC + (dir * 3 + 1) * 64 + 16 * lt + 4 * g);
#pragma unroll
                    for (int rg = 0; rg < 4; ++rg) { const int lk = 16 * lt + 4 * g + rg;
                        const bool valid = dir == 0 ? (lk <= j) : (lk >= j);
                        const float w = TYPE == 0 ? __expf(cj + uv[rg] - mq) : __expf(lg * (float)(dir == 0 ? j - lk : lk - j));
                        const float sv = valid ? sT[rg] * w : 0.f;
                        den += sv; sw[lt][rg] = sv; }
                } else {
#pragma unroll
                    for (int rg = 0; rg < 4; ++rg) sw[lt][rg] = 0.f;
                }
            }
            f32x4 accS[4], accI[4];
#pragma unroll
            for (int et = 0; et < 4; ++et) { accS[et] = (f32x4){0.f, 0.f, 0.f, 0.f}; accI[et] = (f32x4){0.f, 0.f, 0.f, 0.f}; }
#pragma unroll
            for (int ks = 0; ks < 2; ++ks) {
                const bool act = dir == 0 ? (2 * ks <= jt) : (2 * ks + 1 >= jt);
                if (act) { float p[8];
#pragma unroll
                    for (int i = 0; i < 4; ++i) { p[i] = sw[2 * ks][i]; p[4 + i] = sw[2 * ks + 1][i]; }
                    const bf16x8 pf = as_frag(pack8(p));
#pragma unroll
                    for (int et = 0; et < 4; ++et) accS[et] = mfma16(vf[ks][et], pf, accS[et]); }
            }
            const bf16* CP = (const bf16*)(ws + (TYPE == 0 ? WS_CPREV : WS_RPREV)) + ((size_t)(seq0 + dir) * NCH + cc) * 4096;
#pragma unroll
            for (int et = 0; et < 4; ++et)
#pragma unroll
                for (int s = 0; s < 2; ++s) { const bf16x8 cf = as_frag(*(const v4u*)(CP + (16 * et + fr) * 64 + 32 * s + 8 * g)); accI[et] = mfma16(cf, qf[s], accI[et]); }
            if (TYPE == 0) {
                den += shx(den, 16, lane); den += shx(den, 32, lane);
                float qn = qnp[dir]; qn += shx(qn, 16, lane); qn += shx(qn, 32, lane);
                const float dd = aw * qn + den;
                const float dn = 1.0f / fmaxf(fabsf(dd), __expf(-mq));
#pragma unroll
                for (int et = 0; et < 4; ++et) hs[et] = hs[et] + (accI[et] * aw + accS[et]) * dn;
            } else {
#pragma unroll
                for (int et = 0; et < 4; ++et) hs[et] = hs[et] + accS[et] + accI[et] * aw;
            }
        }
        float ss = 0.f;
#pragma unroll
        for (int et = 0; et < 4; ++et) ss += (hs[et][0] * hs[et][0] + hs[et][1] * hs[et][1]) + (hs[et][2] * hs[et][2] + hs[et][3] * hs[et][3]);
        ss += shx(ss, 16, lane); ss += shx(ss, 32, lane);
        const float rn = rsqrtf(ss * (1.0f / 64.0f) + EPS);
        const unsigned char* gp2 = ws + WS_DLT + ((size_t)((TYPE == 0 ? 0 : 4) + h) * MT + row0 + j) * 64 + 4 * g;
        unsigned char* op = (unsigned char*)MIX + (size_t)(row0 + j) * D + (TYPE == 0 ? 0 : 768) + h * 64 + 4 * g;
#pragma unroll
        for (int et = 0; et < 4; ++et) {
            const int gr = *(const int*)(gp2 + 16 * et); const f32x4 nv = *(const f32x4*)(nw + 16 * et + 4 * g);
            const auto g01 = __builtin_amdgcn_cvt_pk_f32_fp8(gr, false), g23 = __builtin_amdgcn_cvt_pk_f32_fp8(gr, true);
            const float gz[4] = {g01[0] * GSC_INV, g01[1] * GSC_INV, g23[0] * GSC_INV, g23[1] * GSC_INV};
            float o[4];
#pragma unroll
            for (int i = 0; i < 4; ++i) o[i] = hs[et][i] * rn * nv[i] * (TYPE == 0 ? sigmoidf_(gz[i]) : siluf_(gz[i]));
            *(unsigned*)(op + 16 * et) = pg8::pk4_fp8(o[0], o[1], o[2], o[3]);
        }
    }
}

__device__ __forceinline__ void mix_unit(int l, LAS unsigned char* lds, int v, bool cout_) {
    constexpr int N_NA = NB * 128 * 8, N_NAC = NB * 4 * 8, N_U2 = NB * NCH * 4;
    if (v < N_NA) { unit_na2(l, lds, v >> 10, (v >> 3) & 127, v & 7, false); return; }
    int w = v - N_NA;
    if (w < N_NAC) { if (cout_) unit_na2(l, lds, w >> 5, (w >> 3) & 3, w & 7, true); return; }
    w -= N_NAC;
    const int ty = w / N_U2, r2 = w % N_U2, h = r2 & 3, cc = (r2 >> 2) % NCH, b = (r2 >> 2) / NCH;
    if (cc < 4 && !cout_) return;
    if (ty == 0) unit_out2<0>(l, lds, b, cc, h); else unit_out2<1>(l, lds, b, cc, h);
}
__device__ __forceinline__ void phase_mixout(int l, LAS unsigned char* lds) {
    const int G = gridDim.x;
    const bool cout_ = l < DEPTH - 1;
    constexpr int N_NA = NB * 128 * 8, N_NAC = NB * 4 * 8, N_U2 = NB * NCH * 4, N_ALL = N_NA + N_NAC + 2 * N_U2;
    const int wave_ = __builtin_amdgcn_readfirstlane(opq_tid() >> 6), gw = vcu_of((int)blockIdx.x, G) * NWAVES + wave_, NW = G * NWAVES;
    if (NW == 2048 && G * 4 == NA_EARLY) {
        mix_unit(l, lds, NA_EARLY + gw, cout_);
        if (gw < 1024) mix_unit(l, lds, NA_EARLY + 2048 + gw, cout_);
        else { mix_unit(l, lds, N_NA + (gw - 1024), cout_); mix_unit(l, lds, N_NA + 1024 + (gw - 1024), cout_); }
        for (int v = N_NA + 2048 + gw; v < N_ALL; v += 2048) mix_unit(l, lds, v, cout_);
    } else {
        for (int v = gw; v < N_ALL; v += NW) mix_unit(l, lds, v, cout_);
    }
}

constexpr int N_PHASES = 2 + 10 * DEPTH;
__device__ __forceinline__ void outproj_ctx(int l) {
    KArgs& A = get_args();
    const int tid = opq_tid(), lane = tid & 63, wave = __builtin_amdgcn_readfirstlane(tid >> 6), fr = lane & 15, fq = lane >> 4;
    unsigned char* ws = A.ws;
    const unsigned char* MIX8 = ws + WS_MIX; const unsigned char* W = ws + WS_WOUT + (size_t)l * D * D;
    bf16* X = (bf16*)(ws + WS_X); const float* g1 = (const float*)(ws + WS_MOD) + (size_t)l * 5 * 6144 + 2 * 1024 + 4 * 6144;
    const int f8scale = 0x7f7f7f7f;
    for (int mu = blockIdx.x; mu < 256; mu += gridDim.x) {
        const int rg = mu >> 2, ct = mu & 3;
        const int row = ML + rg * 16 + fr, c0 = ct * 256 + wave * 32;
        const unsigned char* ap = MIX8 + (size_t)row * D + 32 * fq;
        const unsigned char* bp0 = W + (size_t)(c0 + fr) * D + 32 * fq; const unsigned char* bp1 = bp0 + (size_t)16 * D;
        f32x4 acc0 = (f32x4){0.f, 0.f, 0.f, 0.f}, acc1 = (f32x4){0.f, 0.f, 0.f, 0.f};
#pragma unroll
        for (int t = 0; t < 8; ++t) {
            const pg8::v8i_t a = *(const pg8::v8i_t*)(ap + 128 * t), b0 = *(const pg8::v8i_t*)(bp0 + 128 * t), b1 = *(const pg8::v8i_t*)(bp1 + 128 * t);
            asm volatile("v_mfma_scale_f32_16x16x128_f8f6f4 %0, %1, %2, %0, %3, %3 op_sel_hi:[0,0,0]" : "+v"(acc0) : "v"(b0), "v"(a), "v"(f8scale));
            asm volatile("v_mfma_scale_f32_16x16x128_f8f6f4 %0, %1, %2, %0, %3, %3 op_sel_hi:[0,0,0]" : "+v"(acc1) : "v"(b1), "v"(a), "v"(f8scale));
        }
        asm volatile("s_nop 15\n\ts_nop 15" ::: "memory");
#pragma unroll
        for (int n = 0; n < 2; ++n) { const int c = c0 + 16 * n + 4 * fq; bf16* xp = X + (size_t)row * D + c;
            const v2u xi = *(const v2u*)xp; const f32x4 gv = *(const f32x4*)(g1 + c) * pg8::WSC_INV; const f32x4 ac = n == 0 ? acc0 : acc1;
            const f32x4 v = (f32x4){bflo(xi.x), bfhi(xi.x), bflo(xi.y), bfhi(xi.y)} + ac * gv;
            v2u w; w.x = cvt_pk_bf16(v[0], v[1]); w.y = cvt_pk_bf16(v[2], v[3]); *(v2u*)xp = w; }
    }
}

__global__ void __launch_bounds__(NTHR, 2) fwd_kernel(Args args) {
    extern __shared__ __attribute__((aligned(16))) unsigned char lds_raw[];
    LAS unsigned char* lds = (LAS unsigned char*)lds_raw;
    const int tid = threadIdx.x;
    for (int u = tid; u < (LDS_BYTES - LDSCTL_OFF) / 4; u += NTHR) ((LAS unsigned*)(lds + LDSCTL_OFF))[u] = 0u;
    __syncthreads();
    unsigned* ctl = (unsigned*)(args.ws + WS_CTL);
    XcdBarrier bar; bar.bar = ctl + CW_BAR; bar.x = 0; bar.st = nullptr;
#if MK_ONE_LAUNCH
    bar = xcd_barrier_post(ctl + CW_BAR, (volatile LAS unsigned*)(lds + LDSCTL_OFF));
#endif
    const int lo = args.ph_lo, hi = args.ph_hi;
#define IN(k) (lo <= (k) && (k) < hi)
#if MK_ONE_LAUNCH
#define SEAM(k) do { if (IN(k) && IN((k) + 1)) xcd_barrier(bar); } while (0)
#else
#define SEAM(k) do { } while (0)
#endif
    LAS int* lctl = (LAS int*)(lds + LDSCTL_OFF + 256);
    const int G = gridDim.x;
    if (IN(0)) { phase_prologue(lds); } SEAM(0);
    for (int l = 0; l < DEPTH; ++l) {
        const int p0 = 1 + 10 * l;
        if (IN(p0 + 0)) { phase_norm1<0>(l, lds); } SEAM(p0 + 0);
        if (IN(p0 + 1)) {
            KArgs& A = get_args(); unsigned char* ws = A.ws;
            pg8::DenseSched S; S.init(ws + WS_ACT, ws + WS_WIN + (size_t)l * NPX * D, MT, NPX, G, (int)blockIdx.x, (size_t)256 * 1024);
            { pg8::DenseSched S0 = S; S0.nN = 9; S0.nwg = S0.nM * 9; S0.part(0xEDBA54310ull, 0);
              pg8::EpiInProj<false> E0{(bf16*)(ws + WS_PX), MT, (bf16*)(ws + WS_VTB), ws + WS_DLT, (const float*)(ws + WS_ROPE), ws + WS_QK2};
              pg8::gemm_phase<pg8::EpiInProj<false>, pg8::DenseSched>(lds, S0, E0); }
            __syncthreads();
            { pg8::DenseSched S1 = S; S1.nN = 2; S1.nwg = S1.nM * 2; S1.part(0x76ull, S.nM * 9);
              pg8::EpiInProjK E1{(bf16*)(ws + WS_KN), A.in[I_KNORM] + l * 64};
              pg8::gemm_phase<pg8::EpiInProjK, pg8::DenseSched>(lds, S1, E1); }
            __syncthreads();
            { pg8::DenseSched S2 = S; S2.nN = 4; S2.nwg = S2.nM * 4; S2.part(0xC982ull, S.nM * 11);
              pg8::EpiInProj<true> E2{(bf16*)(ws + WS_PX), MT, (bf16*)(ws + WS_VTB), ws + WS_DLT, (const float*)(ws + WS_ROPE), ws + WS_QK2};
              pg8::gemm_phase<pg8::EpiInProj<true>, pg8::DenseSched>(lds, S2, E2); }
        } SEAM(p0 + 1);
        if (IN(p0 + 2)) { phase_prepass(l); } SEAM(p0 + 2);
        if (IN(p0 + 3)) { phase_stats(l, lds); } SEAM(p0 + 3);
        if (IN(p0 + 4)) { phase_scan(l, lds); } SEAM(p0 + 4);
        if (IN(p0 + 5)) { phase_mixout(l, lds); } SEAM(p0 + 5);
        if (IN(p0 + 6)) {
            KArgs& A = get_args(); unsigned char* ws = A.ws;
            pg8::DenseSched S; S.init(ws + WS_MIX, ws + WS_WOUT + (size_t)l * D * D, ML, D, G, (int)blockIdx.x, (size_t)256 * 1024);
            pg8::EpiResGate E{(bf16*)(ws + WS_X), (const float*)(ws + WS_MOD) + (size_t)l * 5 * 6144 + 2 * 1024};
            pg8::gemm_phase<pg8::EpiResGate, pg8::DenseSched>(lds, S, E);
            if (l < DEPTH - 1) outproj_ctx(l);
        } SEAM(p0 + 6);
        if (IN(p0 + 7)) { phase_norm2(l, lds); } SEAM(p0 + 7);
        if (IN(p0 + 8)) {
            KArgs& A = get_args(); unsigned char* ws = A.ws;
            moe_offsets(l, lctl);
            pg8::MoeSched<true> S{lctl, lctl + 64, (const char*)(ws + WS_ACT), (const char*)(ws + WS_WUP) + (size_t)l * NE * 2048 * D, (const int*)(ws + WS_ROWTOK), (size_t)2048 * D, lctl[32], 8, G, vcu_of((int)blockIdx.x, G)};
            pg8::EpiSwiglu E{(unsigned char*)(ws + WS_H), A.in[I_BUP] + (size_t)l * NE * 2048};
            pg8::gemm_phase<pg8::EpiSwiglu, pg8::MoeSched<true>>(lds, S, E);
        } SEAM(p0 + 8);
        if (IN(p0 + 9)) {
            KArgs& A = get_args(); unsigned char* ws = A.ws;
            moe_offsets(l, lctl);
            pg8::MoeSched<false> S{lctl, lctl + 64, (const char*)(ws + WS_H), (const char*)(ws + WS_WDN) + (size_t)l * NE * D * D, nullptr, (size_t)D * D, lctl[32], 4, G, vcu_of((int)blockIdx.x, G)};
            pg8::EpiDown E{(unsigned char*)(ws + WS_Y), A.in[I_BDN] + (size_t)l * NE * D, (const float*)(ws + WS_ROWGATE)};
            pg8::gemm_phase<pg8::EpiDown, pg8::MoeSched<false>>(lds, S, E);
        } SEAM(p0 + 9);
    }
    if (IN(N_PHASES - 1)) { phase_norm1<1>(0, lds); }
#undef IN
#undef SEAM
}

extern "C" void kernel_launch(void* const* d_in, const int* in_sizes, int n_in, void* d_out, int out_size, void* d_ws, size_t ws_size, hipStream_t stream) {
    static int grid = 0;
    if (grid == 0) {
        if (n_in != 24 || in_sizes[0] != ML * D || out_size != ML * D || ws_size < WS_END) { fprintf(stderr, "kernel_launch: unexpected shapes (n_in %d, in0 %d, out %d, ws %zu)\n", n_in, n_in > 0 ? in_sizes[0] : -1, out_size, ws_size); grid = -1; return; }
        int dev = 0, cus = 0, per_cu = 0;
        if (hipGetDevice(&dev) != hipSuccess || hipDeviceGetAttribute(&cus, hipDeviceAttributeMultiprocessorCount, dev) != hipSuccess) { grid = -1; return; }
        if (hipFuncSetAttribute((const void*)fwd_kernel, hipFuncAttributeMaxDynamicSharedMemorySize, LDS_BYTES) != hipSuccess) { fprintf(stderr, "kernel_launch: hipFuncSetAttribute failed\n"); grid = -1; return; }
        if (hipOccupancyMaxActiveBlocksPerMultiprocessor(&per_cu, (const void*)fwd_kernel, NTHR, LDS_BYTES) != hipSuccess || per_cu < 1) { fprintf(stderr, "kernel_launch: occupancy query says %d\n", per_cu); }
        (void)hipGetLastError();
        grid = cus;
    }
    if (grid < 0) return;
    (void)hipMemsetAsync((char*)d_ws + WS_CTL, 0, CTL_ZERO_BYTES, stream);
    Args a{};
    for (int i = 0; i < 24; ++i) a.in[i] = (const float*)d_in[i];
    a.out = (float*)d_out; a.ws = (unsigned char*)d_ws;
#if MK_ONE_LAUNCH
    a.ph_lo = 0; a.ph_hi = N_PHASES;
    hipLaunchKernelGGL(fwd_kernel, dim3(grid), dim3(NTHR), LDS_BYTES, stream, a);
#else
    for (int p = 0; p < N_PHASES; ++p) { a.ph_lo = p; a.ph_hi = p + 1; hipLaunchKernelGGL(fwd_kernel, dim3(grid), dim3(NTHR), LDS_BYTES, stream, a); }
#endif
}
```
